# Optimizing an MI355X kernel written in HIP

```python
import jax, jax.numpy as jnp
from jax import lax
import numpy as np

D_MODEL = 2048
BATCH = 8
SEQ = 2048
DEPTH = 1

MLA_HEADS = 8
MLA_Q_RANK = 512
MLA_KV_RANK = 512
MLA_NOPE_DIM = 128
MLA_ROPE_DIM = 64
MLA_V_DIM = 128
MLA_WIDTH = MLA_HEADS * MLA_V_DIM
MLA_IN = MLA_Q_RANK + MLA_KV_RANK + MLA_ROPE_DIM
ROPE_THETA = 10000.0
Q_BLOCK = 128

RWKV_HEAD = 64
RWKV_HEADS = 16
RWKV_WIDTH = RWKV_HEADS * RWKV_HEAD
DECAY_RANK = 96
ICLR_RANK = 96
RWKV_SIZES = [RWKV_WIDTH, RWKV_WIDTH, RWKV_WIDTH, DECAY_RANK, DECAY_RANK, ICLR_RANK, ICLR_RANK]
RWKV_IN = sum(RWKV_SIZES)
GN_EPS = 64e-5
NORM_EPS = 1e-6

IN_SIZES = [MLA_IN, RWKV_IN, MLA_WIDTH, RWKV_WIDTH, D_MODEL, D_MODEL]
D_IN = sum(IN_SIZES)

kernel_name = "hybrid_mla_rwkv7_gated_encoder_block"


def _offsets(sizes):
    return [int(o) for o in np.cumsum(sizes)[:-1]]


def rms_norm(x, g, eps=NORM_EPS):
    xf = x.astype(jnp.float32)
    y = xf * lax.rsqrt(jnp.mean(xf * xf, axis=-1, keepdims=True) + eps)
    return (y * g.astype(jnp.float32)).astype(x.dtype)


def apply_rotary(t, cos, sin):
    tf = t.astype(jnp.float32)
    t1, t2 = jnp.split(tf, 2, axis=-1)
    return jnp.concatenate([t1 * cos - t2 * sin, t1 * sin + t2 * cos], axis=-1).astype(t.dtype)


def centred_shift(p):
    pad = jnp.pad(p, ((0, 0), (1, 1), (0, 0)))
    return 0.5 * (pad[:, :-2] + pad[:, 2:])


def mla_attention(q_nope, q_rope, k_nope, k_rope, v):
    B, S, H, _ = q_nope.shape
    nb = S // Q_BLOCK
    scale = (MLA_NOPE_DIM + MLA_ROPE_DIM) ** -0.5
    qn = q_nope.reshape(B, nb, Q_BLOCK, H, MLA_NOPE_DIM).transpose(1, 0, 2, 3, 4)
    qr = q_rope.reshape(B, nb, Q_BLOCK, H, MLA_ROPE_DIM).transpose(1, 0, 2, 3, 4)

    def block(args):
        qn_b, qr_b = args
        s = (jnp.einsum('bqhd,bkhd->bhqk', qn_b, k_nope, preferred_element_type=jnp.float32)
             + jnp.einsum('bqhr,bkr->bhqk', qr_b, k_rope, preferred_element_type=jnp.float32))
        p = jax.nn.softmax(s * scale, axis=-1)
        return jnp.einsum('bhqk,bkhd->bqhd', p.astype(v.dtype), v)

    o = lax.map(block, (qn, qr))
    return o.transpose(1, 0, 2, 3, 4).reshape(B, S, H * MLA_V_DIM)


def rwkv7_bidir_scan(r, w_f, w_b, k_f, k_b, v, kk, a_f, a_b):
    B, S, H, N = r.shape

    def tm(fwd, bwd):
        return jnp.stack([fwd, bwd[:, ::-1]], axis=0).transpose(2, 0, 1, 3, 4)

    xs = (tm(r, r), tm(w_f, w_b), tm(k_f, k_b), tm(v, v), tm(-kk, -kk), tm(kk * a_f, kk * a_b))

    def step(st, inp):
        r_t, w_t, k_t, v_t, a_t, b_t = inp
        sa = jnp.einsum('dbhij,dbhj->dbhi', st, a_t)
        st = st * w_t[..., None, :] + sa[..., None] * b_t[..., None, :] + v_t[..., None] * k_t[..., None, :]
        y = jnp.einsum('dbhij,dbhj->dbhi', st, r_t)
        return st, y

    s0 = jnp.zeros((2, B, H, N, N), jnp.float32)
    _, ys = lax.scan(step, s0, xs)
    y = ys[:, 0] + ys[::-1, 1]
    return y.transpose(1, 0, 2, 3)


def setup_inputs(seed: int = 0) -> dict:
    key = jax.random.key(seed)
    ks = jax.random.split(key, 32)
    f32 = jnp.float32
    nrm = lambda k, shape, s: jax.random.normal(k, shape, f32) * s
    gain = lambda k, n: 1.0 + nrm(k, (n,), 0.02)
    return {
        "x": nrm(ks[0], (BATCH, SEQ, D_MODEL), 1.0),
        "g_pre": gain(ks[1], D_MODEL),
        "w_in": nrm(ks[2], (D_MODEL, D_IN), D_MODEL ** -0.5),
        "mla_q_norm": gain(ks[3], MLA_Q_RANK),
        "mla_wq_b": nrm(ks[4], (MLA_Q_RANK, MLA_HEADS * (MLA_NOPE_DIM + MLA_ROPE_DIM)), MLA_Q_RANK ** -0.5),
        "mla_kv_norm": gain(ks[5], MLA_KV_RANK),
        "mla_wkv_b": nrm(ks[6], (MLA_KV_RANK, MLA_HEADS * (MLA_NOPE_DIM + MLA_V_DIM)), MLA_KV_RANK ** -0.5),
        "rwkv_mu": jax.random.uniform(ks[7], (RWKV_IN,), f32),
        "rwkv_w0_f": nrm(ks[8], (RWKV_WIDTH,), 0.5),
        "rwkv_w2_f": nrm(ks[9], (DECAY_RANK, RWKV_WIDTH), 0.5 * DECAY_RANK ** -0.5),
        "rwkv_w0_b": nrm(ks[10], (RWKV_WIDTH,), 0.5),
        "rwkv_w2_b": nrm(ks[11], (DECAY_RANK, RWKV_WIDTH), 0.5 * DECAY_RANK ** -0.5),
        "rwkv_a0_f": nrm(ks[12], (RWKV_WIDTH,), 0.1),
        "rwkv_a2_f": nrm(ks[13], (ICLR_RANK, RWKV_WIDTH), 0.5 * ICLR_RANK ** -0.5),
        "rwkv_a0_b": nrm(ks[14], (RWKV_WIDTH,), 0.1),
        "rwkv_a2_b": nrm(ks[15], (ICLR_RANK, RWKV_WIDTH), 0.5 * ICLR_RANK ** -0.5),
        "rwkv_k_k": 0.85 + nrm(ks[16], (RWKV_WIDTH,), 0.02),
        "rwkv_k_a": gain(ks[17], RWKV_WIDTH),
        "rwkv_r_k": nrm(ks[18], (RWKV_HEADS, RWKV_HEAD), 0.1),
        "rwkv_gn_g": gain(ks[19], RWKV_WIDTH),
        "rwkv_gn_b": nrm(ks[20], (RWKV_WIDTH,), 0.01),
        "w_br_mla": nrm(ks[21], (MLA_WIDTH, D_MODEL), MLA_WIDTH ** -0.5),
        "w_br_rwkv": nrm(ks[22], (RWKV_WIDTH, D_MODEL), RWKV_WIDTH ** -0.5),
        "w_out": nrm(ks[23], (D_MODEL, D_MODEL), D_MODEL ** -0.5),
        "g_post": gain(ks[24], D_MODEL),
    }


def reference(x, g_pre, w_in, mla_q_norm, mla_wq_b, mla_kv_norm, mla_wkv_b, rwkv_mu,
              rwkv_w0_f, rwkv_w2_f, rwkv_w0_b, rwkv_w2_b, rwkv_a0_f, rwkv_a2_f, rwkv_a0_b,
              rwkv_a2_b, rwkv_k_k, rwkv_k_a, rwkv_r_k, rwkv_gn_g, rwkv_gn_b, w_br_mla,
              w_br_rwkv, w_out, g_post):
    f32 = jnp.float32
    B, S, _ = x.shape
    pos = jnp.arange(S, dtype=f32)
    inv_freq = jnp.power(ROPE_THETA, -jnp.arange(0, MLA_ROPE_DIM, 2, dtype=f32) / MLA_ROPE_DIM)
    ang = pos[:, None] * inv_freq[None, :]
    cos, sin = jnp.cos(ang), jnp.sin(ang)

    for _layer in range(DEPTH):
        h = rms_norm(x, g_pre)
        proj = h @ w_in
        mla_in, rwkv_in, z_mla, z_rwkv, gate_mla, gate_rwkv = jnp.split(proj, _offsets(IN_SIZES), axis=-1)

        q_a, kv_a, k_rope = jnp.split(mla_in, _offsets([MLA_Q_RANK, MLA_KV_RANK, MLA_ROPE_DIM]), axis=-1)
        q = (rms_norm(q_a, mla_q_norm) @ mla_wq_b).reshape(B, S, MLA_HEADS, MLA_NOPE_DIM + MLA_ROPE_DIM)
        kv = (rms_norm(kv_a, mla_kv_norm) @ mla_wkv_b).reshape(B, S, MLA_HEADS, MLA_NOPE_DIM + MLA_V_DIM)
        q_nope, q_rope = q[..., :MLA_NOPE_DIM], q[..., MLA_NOPE_DIM:]
        k_nope, v_mla = kv[..., :MLA_NOPE_DIM], kv[..., MLA_NOPE_DIM:]
        q_rope = apply_rotary(q_rope, cos[:, None, :], sin[:, None, :])
        k_rope = apply_rotary(k_rope, cos, sin)
        y_mla = mla_attention(q_nope, q_rope, k_nope, k_rope, v_mla)

        rin = rwkv_in.astype(f32)
        rin = rin + rwkv_mu * (centred_shift(rin) - rin)
        r, k, v, wd_f, wd_b, ad_f, ad_b = jnp.split(rin, _offsets(RWKV_SIZES), axis=-1)

        def decay(w0, wd, w2):
            z = w0 + jnp.tanh(wd) @ w2
            return jnp.exp(-jnp.exp(-jax.nn.softplus(-z) - 0.5))

        w_f = decay(rwkv_w0_f.astype(f32), wd_f, rwkv_w2_f.astype(f32))
        w_b = decay(rwkv_w0_b.astype(f32), wd_b, rwkv_w2_b.astype(f32))
        a_f = jax.nn.sigmoid(rwkv_a0_f.astype(f32) + ad_f @ rwkv_a2_f.astype(f32))
        a_b = jax.nn.sigmoid(rwkv_a0_b.astype(f32) + ad_b @ rwkv_a2_b.astype(f32))

        hd = lambda t: t.reshape(B, S, RWKV_HEADS, RWKV_HEAD)
        kk = hd(k * rwkv_k_k.astype(f32))
        kk = kk / jnp.maximum(jnp.linalg.norm(kk, axis=-1, keepdims=True), 1e-12)
        k_a = rwkv_k_a.astype(f32)
        k_f = k * (1.0 + (a_f - 1.0) * k_a)
        k_b = k * (1.0 + (a_b - 1.0) * k_a)
        r_h, v_h, k_fh, k_bh = hd(r), hd(v), hd(k_f), hd(k_b)
        y = rwkv7_bidir_scan(r_h, hd(w_f), hd(w_b), k_fh, k_bh, v_h, kk, hd(a_f), hd(a_b))
        mu = jnp.mean(y, axis=-1, keepdims=True)
        var = jnp.mean(jnp.square(y - mu), axis=-1, keepdims=True)
        yn = ((y - mu) * lax.rsqrt(var + GN_EPS)).reshape(B, S, RWKV_WIDTH)
        yn = yn * rwkv_gn_g.astype(f32) + rwkv_gn_b.astype(f32)
        bonus = jnp.sum(r_h * (k_fh + k_bh) * rwkv_r_k.astype(f32), axis=-1, keepdims=True) * v_h
        y_rwkv = (yn + bonus.reshape(B, S, RWKV_WIDTH)).astype(x.dtype)

        u_mla = (y_mla * jax.nn.silu(z_mla)) @ w_br_mla
        u_rwkv = (y_rwkv * jax.nn.silu(z_rwkv)) @ w_br_rwkv
        merged = jax.nn.sigmoid(gate_mla) * u_mla + jax.nn.sigmoid(gate_rwkv) * u_rwkv
        out = merged @ w_out
        x = (x + rms_norm(out, g_post)).astype(x.dtype)
    return x
```

```cpp
#include <hip/hip_runtime.h>
#include <hip/hip_cooperative_groups.h>
#include <cstdio>
#include <cstdint>
namespace cg = cooperative_groups;

#ifndef PH_MASK
#define PH_MASK 0x1ff
#endif
#define PHEN(i) ((PH_MASK >> (i)) & 1)
#ifndef DBL_MASK
#define DBL_MASK 0
#endif
#define DBLN(i) (1 + ((DBL_MASK >> (i)) & 1))
#ifndef N_LAUNCHES
#define N_LAUNCHES 1
#endif

constexpr int T = 16384, SEQ = 2048, DM = 2048, DIN = 10688;
constexpr int NP1 = 10752;
constexpr size_t MiB = 1u << 20;
constexpr size_t WS_WQ = 0, WS_WKV = WS_WQ + 1536 * 512 * 2, WS_LW = WS_WKV + 2048 * 512 * 2, WS_LA = WS_LW + 2048 * 256 * 2, WS_WBM = WS_LA + 2048 * 256 * 2,
                 WS_WBR = WS_WBM + 2048 * 1024 * 2, WS_WOUT = WS_WBR + 2048 * 1024 * 2, WS_CS = WS_WOUT + 2048 * 2048 * 2, WS_SSQ = WS_CS + 2048 * 32 * 8,
                 WS_SMALL_END = WS_SSQ + (size_t)T * 16 * 4;
static_assert(WS_SMALL_END <= 23 * MiB, "small region");
constexpr size_t WS_RKV = 23 * MiB, WS_Z = 119 * MiB, WS_KROPE = 183 * MiB, WS_H = 185 * MiB  , WS_Q = WS_H, WS_AW = 233 * MiB, WS_AA = 241 * MiB,
                 WS_KV = 249 * MiB  , WS_WIN = 313 * MiB, WS_QA = 355 * MiB, WS_KVA = 371 * MiB, WS_MISC = 387 * MiB, WS_UA = 313 * MiB  ,
                 WS_YF = 185 * MiB, WS_YB = 249 * MiB, WS_TMP = 313 * MiB, WS_MERGED = 185 * MiB, WS_ORAW = 313 * MiB  , WS_BAR = 441 * MiB, WS_END = 441 * MiB + 16384;

typedef unsigned short bf16_t;
typedef short bf16x8 __attribute__((ext_vector_type(8)));
typedef short s16x4 __attribute__((ext_vector_type(4)));
typedef float f32x4 __attribute__((ext_vector_type(4)));
typedef float f32x16 __attribute__((ext_vector_type(16)));
typedef unsigned u32x4 __attribute__((ext_vector_type(4)));
typedef float f32x2 __attribute__((ext_vector_type(2)));

struct Params {
    const float *x, *g_pre, *w_in, *q_norm, *wq_b, *kv_norm, *wkv_b, *mu, *w0_f, *w2_f, *w0_b, *w2_b, *a0_f, *a2_f, *a0_b, *a2_b, *k_k, *k_a, *r_k, *gn_g, *gn_b, *w_br_mla, *w_br_rwkv, *w_out, *g_post;
    float* out; unsigned char* ws; int ph_lo, ph_hi;
};

__device__ __forceinline__ unsigned cvt_pk_bf16(float lo, float hi) { unsigned r; asm volatile("v_cvt_pk_bf16_f32 %0, %1, %2" : "=v"(r) : "v"(lo), "v"(hi)); return r; }
__device__ __forceinline__ float bf2f(bf16_t b) { return __uint_as_float(((unsigned)b) << 16); }
__device__ __forceinline__ bf16_t f2bf(float f) { return (bf16_t)(cvt_pk_bf16(f, 0.f) & 0xffffu); }
__device__ __forceinline__ float h2f(unsigned short h) { _Float16 v; __builtin_memcpy(&v, &h, 2); return (float)v; }
__device__ __forceinline__ unsigned pk_f16(float a, float b) { _Float16 x = (_Float16)a, y = (_Float16)b; unsigned short xs, ys; __builtin_memcpy(&xs, &x, 2); __builtin_memcpy(&ys, &y, 2); return (unsigned)xs | ((unsigned)ys << 16); }
__device__ __forceinline__ float sigmoidf_(float v) { return __builtin_amdgcn_rcpf(1.f + __expf(-v)); }
__device__ __forceinline__ float wave_sum(float v) {
#pragma unroll
    for (int o = 1; o < 64; o <<= 1) v += __shfl_xor(v, o);
    return v;
}
template <int CTRL> __device__ __forceinline__ float dppx(float v) { return __int_as_float(__builtin_amdgcn_update_dpp(0, __float_as_int(v), CTRL, 0xF, 0xF, true)); }
__device__ __forceinline__ float red8(float v) { v += dppx<0xB1>(v); v += dppx<0x4E>(v); v += dppx<0x141>(v); return v; }
__device__ __forceinline__ float red16(float v) { v = red8(v); v += dppx<0x140>(v); return v; }
__device__ __forceinline__ float wave_sum_fast(float v) { v = red16(v); const int iv = __float_as_int(v);
    return (__int_as_float(__builtin_amdgcn_readlane(iv, 0)) + __int_as_float(__builtin_amdgcn_readlane(iv, 16))) + (__int_as_float(__builtin_amdgcn_readlane(iv, 32)) + __int_as_float(__builtin_amdgcn_readlane(iv, 48))); }
typedef unsigned u32x2 __attribute__((ext_vector_type(2)));
__device__ __forceinline__ void unpack4(u32x2 w, float* v) { v[0] = __uint_as_float(w.x << 16); v[1] = __uint_as_float(w.x & 0xffff0000u); v[2] = __uint_as_float(w.y << 16); v[3] = __uint_as_float(w.y & 0xffff0000u); }
__device__ __forceinline__ void unpack4h(u32x2 w, float* v) { v[0] = h2f((unsigned short)(w.x & 0xffffu)); v[1] = h2f((unsigned short)(w.x >> 16)); v[2] = h2f((unsigned short)(w.y & 0xffffu)); v[3] = h2f((unsigned short)(w.y >> 16)); }
__device__ __forceinline__ u32x4 pack8(const float* v) { u32x4 w; w.x = cvt_pk_bf16(v[0], v[1]); w.y = cvt_pk_bf16(v[2], v[3]); w.z = cvt_pk_bf16(v[4], v[5]); w.w = cvt_pk_bf16(v[6], v[7]); return w; }
__device__ __forceinline__ void unpack8(u32x4 w, float* v) {
    v[0] = __uint_as_float(w.x << 16); v[1] = __uint_as_float(w.x & 0xffff0000u); v[2] = __uint_as_float(w.y << 16); v[3] = __uint_as_float(w.y & 0xffff0000u);
    v[4] = __uint_as_float(w.z << 16); v[5] = __uint_as_float(w.z & 0xffff0000u); v[6] = __uint_as_float(w.w << 16); v[7] = __uint_as_float(w.w & 0xffff0000u);
}

namespace pg8 {
#define PG8_LAS __attribute__((address_space(3)))
constexpr int BM = 256, BK = 64, HALF = 128, HTB = HALF * BK * 2, STAGE_BYTES = 8 * HTB, NXCD = 8, WGM = 8;
__host__ __device__ __forceinline__ int lds_byte(int r, int c) { const int st = (r >> 4) * 2 + (c >> 5), rr = r & 15, cc = c & 31, ob = rr * 64 + cc * 2; return st * 1024 + (ob ^ (((ob >> 9) & 1) << 5)); }
__host__ __device__ __forceinline__ void stage_rc(int b, int& R, int& C) { const int st = b / 1024, sb = b % 1024, swz = sb ^ (((sb >> 9) & 1) << 5); R = (st >> 1) * 16 + swz / 64; C = (st & 1) * 32 + (swz % 64) / 2; }
__host__ __device__ __forceinline__ int perm32(int rho) { const int n = rho >> 4, i = rho & 15; return 8 * (i >> 2) + 4 * n + (i & 3); }
struct Unit { int pm, pn; };
struct Gemm { const bf16_t* A; const bf16_t* Bt; int M, N, K, lda, ldb; };
struct StaticOrder {
    int nM, nN, nwg, G, c;
    __host__ __device__ void init(int M, int N, int G_, int c_) { nM = M / BM; nN = N / BM; nwg = nM * nN; G = G_; c = c_; }
    __host__ __device__ bool next(int i, Unit& u) const {
        const long L = (long)i * G + c; if (L >= nwg) return false;
        int wgid = (int)L; { const int q = nwg / NXCD, r = nwg % NXCD, xcd = wgid % NXCD, off = wgid / NXCD; wgid = (xcd < r ? xcd * (q + 1) : r * (q + 1) + (xcd - r) * q) + off; }
        const int nig = WGM * nN, gid = wgid / nig, fm = gid * WGM, gsz = (nM - fm) < WGM ? (nM - fm) : WGM;
        u.pm = fm + ((wgid % nig) % gsz); u.pn = (wgid % nig) / gsz; return true;
    }
    __device__ __forceinline__ void a_ready(const Unit&) const {}
    __device__ __forceinline__ void done(const Unit&) const {}
};
template <class Epi, class Sched>
__device__ __forceinline__ void gemm_phase(PG8_LAS unsigned char* lds, const Gemm g, const Sched& S, const Epi& E, int tid_in) {
    int tid_l = tid_in; asm volatile("" : "+v"(tid_l));
    const int tid = tid_l, wid = __builtin_amdgcn_readfirstlane(tid >> 6), lane = tid & 63, wr = wid >> 2, wc = wid & 3, fr = lane & 15, fq = lane >> 4;
    const int K = g.K, nt = K / BK;
    unsigned voffA[2], voffB[2];
#pragma unroll
    for (int i = 0; i < 2; ++i) { int R, C; stage_rc(tid * 16 + i * 8192, R, C); const int Rb = Epi::PERM ? ((R & ~31) + perm32(R & 31)) : R;
        voffA[i] = (unsigned)(R * g.lda + C) * 2u; voffB[i] = (unsigned)(Rb * g.ldb + C) * 2u; }
    const size_t kstep = (size_t)(BK * 2);
    const size_t hstepA = (size_t)HALF * g.lda * 2, hstepB = (size_t)HALF * g.ldb * 2;
    const size_t tstepA = 2 * hstepA, tstepB = 2 * hstepB;
    const unsigned ldsw = (unsigned)wid * 1024u;
    const int aoff = lds_byte(wr * 64 + fr, fq * 8), boff = lds_byte(wc * 32 + fr, fq * 8);
#define PG8_SA(b, h) (((b) * 2 + (h)) * HTB)
#define PG8_SB(b, h) ((4 + (b) * 2 + (h)) * HTB)
#define PG8_STAGE(bufoff, gbase, voff) do { _Pragma("unroll") for (int _i = 0; _i < 2; ++_i) \
        __builtin_amdgcn_global_load_lds((const unsigned*)((const char*)(gbase) + (voff)[_i]), (PG8_LAS unsigned*)(lds + (bufoff) + ldsw + _i * 8192), 16, 0, 0); } while (0)
#define PG8_LDA(dst, b, h) do { _Pragma("unroll") for (int m = 0; m < 4; ++m) _Pragma("unroll") for (int k = 0; k < 2; ++k) dst[m][k] = *(const PG8_LAS bf16x8*)(lds + PG8_SA(b, h) + aoff + m * 2048 + k * 1024); } while (0)
#define PG8_LDB(dst, b, h) do { _Pragma("unroll") for (int n = 0; n < 2; ++n) _Pragma("unroll") for (int k = 0; k < 2; ++k) dst[n][k] = *(const PG8_LAS bf16x8*)(lds + PG8_SB(b, h) + boff + n * 2048 + k * 1024); } while (0)
#define PG8_MMA(ai, bj, At, Bt) do { __builtin_amdgcn_s_setprio(1); _Pragma("unroll") for (int m = 0; m < 4; ++m) _Pragma("unroll") for (int n = 0; n < 2; ++n) _Pragma("unroll") for (int k = 0; k < 2; ++k) \
        acc[ai][bj][m][n] = __builtin_amdgcn_mfma_f32_16x16x32_bf16(Bt[n][k], At[m][k], acc[ai][bj][m][n], 0, 0, 0); __builtin_amdgcn_s_setprio(0); } while (0)
#define PG8_WAIT_V(n) asm volatile("s_waitcnt vmcnt(" #n ")" ::: "memory")
#define PG8_WAIT_L(n) asm volatile("s_waitcnt lgkmcnt(" #n ")" ::: "memory")
#define PG8_BAR __builtin_amdgcn_s_barrier()
#define PG8_SCHED __builtin_amdgcn_sched_barrier(0)
    Unit cur, nxt; int ui = 0;
    if (!S.next(0, cur)) return;
    f32x4 acc[2][2][4][2];
#pragma unroll
    for (int a = 0; a < 2; ++a)
#pragma unroll
        for (int b = 0; b < 2; ++b)
#pragma unroll
            for (int m = 0; m < 4; ++m)
#pragma unroll
                for (int n = 0; n < 2; ++n) acc[a][b][m][n] = (f32x4){0.f, 0.f, 0.f, 0.f};
    bf16x8 At[4][2], B0[2][2], B1[2][2];
    const char* cA = (const char*)g.A + (size_t)cur.pm * tstepA; const char* cB = (const char*)g.Bt + (size_t)cur.pn * tstepB;
    S.a_ready(cur);
    PG8_STAGE(PG8_SB(0, 0), cB, voffB); PG8_STAGE(PG8_SA(0, 0), cA, voffA); PG8_STAGE(PG8_SB(0, 1), cB + hstepB, voffB); PG8_STAGE(PG8_SA(0, 1), cA + hstepA, voffA);
    if (wr == 1) PG8_BAR;
    PG8_WAIT_V(4); PG8_BAR;
    PG8_STAGE(PG8_SB(1, 0), cB + kstep, voffB); PG8_STAGE(PG8_SA(1, 0), cA + kstep, voffA); PG8_STAGE(PG8_SB(1, 1), cB + hstepB + kstep, voffB);
    PG8_WAIT_V(6); PG8_BAR;
    for (;;) {
        const bool has_next = S.next(ui + 1, nxt);
        const char* nA = has_next ? (const char*)g.A + (size_t)nxt.pm * tstepA : cA; const char* nB = has_next ? (const char*)g.Bt + (size_t)nxt.pn * tstepB : cB;
        for (int t = 0; t < nt; t += 2) {
            const bool last = (t == nt - 2);
            const char* a1 = cA + (size_t)(t + 1) * kstep;
            const char* a2 = last ? nA : cA + (size_t)(t + 2) * kstep; const char* b2 = last ? nB : cB + (size_t)(t + 2) * kstep;
            const char* a3 = a2 + kstep; const char* b3 = b2 + kstep;
            if (last && has_next) S.a_ready(nxt);
            if constexpr (Epi::MID) { if (t == (nt >> 1)) E.mid(acc, cur, wr, wc, fr, fq); }
            PG8_LDB(B0, 0, 0); PG8_SCHED; PG8_LDA(At, 0, 0); PG8_STAGE(PG8_SA(1, 1), a1 + hstepA, voffA);
            PG8_WAIT_L(8); PG8_BAR; PG8_WAIT_L(0); PG8_MMA(0, 0, At, B0); PG8_BAR; PG8_SCHED;
            PG8_LDB(B1, 0, 1); PG8_STAGE(PG8_SB(0, 0), b2, voffB);
            PG8_BAR; PG8_WAIT_L(0); PG8_MMA(0, 1, At, B1); PG8_BAR;
            PG8_LDA(At, 0, 1); PG8_STAGE(PG8_SA(0, 0), a2, voffA);
            PG8_BAR; PG8_WAIT_L(0); PG8_MMA(1, 0, At, B0); PG8_BAR; PG8_SCHED;
            PG8_STAGE(PG8_SB(0, 1), b2 + hstepB, voffB);
            PG8_WAIT_V(6); PG8_BAR; PG8_MMA(1, 1, At, B1); PG8_BAR;
            PG8_LDB(B0, 1, 0); PG8_SCHED; PG8_LDA(At, 1, 0); PG8_STAGE(PG8_SA(0, 1), a2 + hstepA, voffA);
            PG8_WAIT_L(8); PG8_BAR; PG8_WAIT_L(0); PG8_MMA(0, 0, At, B0); PG8_BAR; PG8_SCHED;
            PG8_LDB(B1, 1, 1); PG8_STAGE(PG8_SB(1, 0), b3, voffB);
            PG8_BAR; PG8_WAIT_L(0); PG8_MMA(0, 1, At, B1); PG8_BAR;
            PG8_LDA(At, 1, 1); PG8_STAGE(PG8_SA(1, 0), a3, voffA);
            PG8_BAR; PG8_WAIT_L(0); PG8_MMA(1, 0, At, B0); PG8_BAR; PG8_SCHED;
            PG8_STAGE(PG8_SB(1, 1), b3 + hstepB, voffB);
            PG8_WAIT_V(6); PG8_BAR; PG8_MMA(1, 1, At, B1); PG8_BAR;
        }
        E(acc, cur, wr, wc, fr, fq); S.done(cur);
        if (!has_next) break;
#pragma unroll
        for (int a = 0; a < 2; ++a)
#pragma unroll
            for (int b = 0; b < 2; ++b)
#pragma unroll
                for (int m = 0; m < 4; ++m)
#pragma unroll
                    for (int n = 0; n < 2; ++n) acc[a][b][m][n] = (f32x4){0.f, 0.f, 0.f, 0.f};
        cur = nxt; cA = nA; cB = nB; ++ui;
    }
    PG8_WAIT_V(0);
    if (wr == 0) PG8_BAR;
    PG8_BAR;
#undef PG8_SA
#undef PG8_SB
#undef PG8_STAGE
#undef PG8_LDA
#undef PG8_LDB
#undef PG8_MMA
#undef PG8_WAIT_V
#undef PG8_WAIT_L
#undef PG8_BAR
#undef PG8_SCHED
}
}
using pg8::Unit;
typedef const f32x4 (&AccRef)[2][2][4][2];

#define EPI_LOOP_ROWS _Pragma("unroll") for (int ai = 0; ai < 2; ++ai) _Pragma("unroll") for (int m = 0; m < 4; ++m)
#define EPI_GET8(v) float v[8]; { const f32x4 x0 = acc[ai][bj][m][0], x1 = acc[ai][bj][m][1]; v[0] = x0[0]; v[1] = x0[1]; v[2] = x0[2]; v[3] = x0[3]; v[4] = x1[0]; v[5] = x1[1]; v[6] = x1[2]; v[7] = x1[3]; }

__device__ __forceinline__ void rope8(float* v, const float* cs, int pos, int p0) {
    const f32x4 c0 = *(const f32x4*)(cs + ((size_t)pos * 32 + p0) * 2), c1 = *(const f32x4*)(cs + ((size_t)pos * 32 + p0 + 2) * 2);
    const float co[4] = {c0[0], c0[2], c1[0], c1[2]}, si[4] = {c0[1], c0[3], c1[1], c1[3]};
#pragma unroll
    for (int q = 0; q < 4; ++q) { const float a = v[2 * q], b = v[2 * q + 1]; v[2 * q] = a * co[q] - b * si[q]; v[2 * q + 1] = a * si[q] + b * co[q]; }
}

struct Epi1 {
    static constexpr bool PERM = true, MID = false;
    bf16_t *qa, *kva, *misc, *krope, *rkv, *z, *g; float* ssq; const float* cs;
    __device__ __forceinline__ void operator()(AccRef acc, const Unit& u, int wr, int wc, int fr, int fq) const {
        const int pn = u.pn, row0 = u.pm * 256 + wr * 64 + fr, cl = wc * 32 + 8 * fq;
        if (pn < 4) {
            bf16_t* dst = pn < 2 ? qa : kva; const int cbase = (pn & 1) * 256 + cl; float* sq = ssq + (pn < 2 ? 0 : 8) + (pn & 1) * 4 + wc;
            EPI_LOOP_ROWS { __builtin_amdgcn_sched_barrier(0); const int row = row0 + ai * 128 + m * 16; float ss = 0.f;
#pragma unroll
                for (int bj = 0; bj < 2; ++bj) { EPI_GET8(v);
#pragma unroll
                    for (int j = 0; j < 8; ++j) ss += v[j] * v[j];
                    __builtin_nontemporal_store(pack8(v), (u32x4*)(dst + (size_t)row * 512 + cbase + bj * 128)); }
                ss += __shfl_xor(ss, 16); ss += __shfl_xor(ss, 32);
                if (fq == 0) sq[(size_t)row * 16] = ss; }
        } else if (pn == 4) {
            EPI_LOOP_ROWS { __builtin_amdgcn_sched_barrier(0); const int row = row0 + ai * 128 + m * 16;
#pragma unroll
                for (int bj = 0; bj < 2; ++bj) { EPI_GET8(v); const int mc = bj * 128 + cl;
                    if (mc < 64) { rope8(v, cs, row & (SEQ - 1), mc >> 1); __builtin_nontemporal_store(pack8(v), (u32x4*)(krope + (size_t)row * 64 + mc)); }
                    else __builtin_nontemporal_store(pack8(v), (u32x4*)(misc + (size_t)row * 512 + mc)); } }
        } else {
            bf16_t* dst; int ld, act;
            if (pn == 5) { dst = misc + 256; ld = 512; act = 0; }
            else if (pn < 18) { dst = rkv + (pn - 6) * 256; ld = 3072; act = 0; }
            else if (pn < 26) { dst = z + (pn - 18) * 256; ld = 2048; act = 1; }
            else { dst = g + (pn - 26) * 256; ld = 4096; act = 2; }
            dst += cl;
            EPI_LOOP_ROWS { __builtin_amdgcn_sched_barrier(0); const int row = row0 + ai * 128 + m * 16;
#pragma unroll
                for (int bj = 0; bj < 2; ++bj) { EPI_GET8(v);
                    if (act) {
#pragma unroll
                        for (int j = 0; j < 8; ++j) { const float sg = sigmoidf_(v[j]); v[j] = act == 1 ? v[j] * sg : sg; } }
                    __builtin_nontemporal_store(pack8(v), (u32x4*)(dst + (size_t)row * ld + bj * 128)); } }
        }
    }
};
__device__ __forceinline__ float rstd_from_ssq(const float* sq) { const f32x4 a = *(const f32x4*)sq, b = *(const f32x4*)(sq + 4); const float s = ((a[0] + a[1]) + (a[2] + a[3])) + ((b[0] + b[1]) + (b[2] + b[3])); return rsqrtf(s * (1.f / 512.f) + 1e-6f); }
struct EpiQ {
    static constexpr bool PERM = true, MID = false;
    bf16_t* q; const float* ssq; const float* cs;
    __device__ __forceinline__ void operator()(AccRef acc, const Unit& u, int wr, int wc, int fr, int fq) const {
        const int row0 = u.pm * 256 + wr * 64 + fr, cl = u.pn * 256 + wc * 32 + 8 * fq;
        float rsv[2][4];
        EPI_LOOP_ROWS rsv[ai][m] = rstd_from_ssq(ssq + (size_t)(row0 + ai * 128 + m * 16) * 16);
        EPI_LOOP_ROWS { __builtin_amdgcn_sched_barrier(0); const int row = row0 + ai * 128 + m * 16; const float rs = rsv[ai][m];
#pragma unroll
            for (int bj = 0; bj < 2; ++bj) { EPI_GET8(v); const int gc = cl + bj * 128, hc = gc % 192;
#pragma unroll
                for (int j = 0; j < 8; ++j) v[j] *= rs;
                if (hc >= 128) rope8(v, cs, row & (SEQ - 1), (hc - 128) >> 1);
                *(u32x4*)(q + (size_t)row * 1536 + gc) = pack8(v); } }
    }
};
struct EpiKV {
    static constexpr bool PERM = true, MID = false;
    bf16_t* kv; const float* ssq;
    __device__ __forceinline__ void operator()(AccRef acc, const Unit& u, int wr, int wc, int fr, int fq) const {
        const int row0 = u.pm * 256 + wr * 64 + fr, cl = u.pn * 256 + wc * 32 + 8 * fq;
        float rsv[2][4];
        EPI_LOOP_ROWS rsv[ai][m] = rstd_from_ssq(ssq + (size_t)(row0 + ai * 128 + m * 16) * 16 + 8);
        EPI_LOOP_ROWS { __builtin_amdgcn_sched_barrier(0); const int row = row0 + ai * 128 + m * 16; const float rs = rsv[ai][m];
#pragma unroll
            for (int bj = 0; bj < 2; ++bj) { EPI_GET8(v);
#pragma unroll
                for (int j = 0; j < 8; ++j) v[j] *= rs;
                *(u32x4*)(kv + (size_t)row * 2048 + cl + bj * 128) = pack8(v); } }
    }
};
struct EpiLora {
    static constexpr bool PERM = true, MID = false;
    unsigned short* ua; int off; const float *bias_f, *bias_b;
    __device__ __forceinline__ void operator()(AccRef acc, const Unit& u, int wr, int wc, int fr, int fq) const {
        const int row0 = u.pm * 256 + wr * 64 + fr, cl = u.pn * 256 + wc * 32 + 8 * fq; const float* bias = u.pn < 4 ? bias_f : bias_b - 1024;
#pragma unroll
        for (int bj = 0; bj < 2; ++bj) { const int gc = cl + bj * 128; const f32x4 b0 = *(const f32x4*)(bias + gc), b1 = *(const f32x4*)(bias + gc + 4);
            EPI_LOOP_ROWS { __builtin_amdgcn_sched_barrier(0); const int row = row0 + ai * 128 + m * 16; EPI_GET8(v);
                u32x4 w; w.x = pk_f16(sigmoidf_(v[0] + b0[0]), sigmoidf_(v[1] + b0[1])); w.y = pk_f16(sigmoidf_(v[2] + b0[2]), sigmoidf_(v[3] + b0[3]));
                w.z = pk_f16(sigmoidf_(v[4] + b1[0]), sigmoidf_(v[5] + b1[1])); w.w = pk_f16(sigmoidf_(v[6] + b1[2]), sigmoidf_(v[7] + b1[3]));
                *(u32x4*)(ua + (size_t)row * 4096 + off + gc) = w; } }
    }
};
struct EpiMerge {
    static constexpr bool PERM = true, MID = true;
    const bf16_t* g; bf16_t* merged;
    __device__ __forceinline__ void mid(f32x4 (&acc)[2][2][4][2], const Unit& u, int wr, int wc, int fr, int fq) const {
        int row0 = u.pm * 256 + wr * 64 + fr, cl = u.pn * 256 + wc * 32 + 8 * fq; asm volatile("" : "+v"(row0), "+v"(cl));
#pragma unroll
        for (int ai = 0; ai < 2; ++ai) { u32x4 w1[4][2], w2[4][2];
            __builtin_amdgcn_sched_barrier(0);
#pragma unroll
            for (int m = 0; m < 4; ++m)
#pragma unroll
                for (int bj = 0; bj < 2; ++bj) { const bf16_t* gp = g + (size_t)(row0 + ai * 128 + m * 16) * 4096 + cl + bj * 128; w1[m][bj] = *(const u32x4*)gp; w2[m][bj] = *(const u32x4*)(gp + 2048); }
            __builtin_amdgcn_sched_barrier(0);
#pragma unroll
            for (int m = 0; m < 4; ++m)
#pragma unroll
                for (int bj = 0; bj < 2; ++bj) { float g1[8], g2[8]; unpack8(w1[m][bj], g1); unpack8(w2[m][bj], g2);
#pragma unroll
                    for (int j = 0; j < 4; ++j) { acc[ai][bj][m][0][j] *= g1[j] * __builtin_amdgcn_rcpf(fmaxf(g2[j], 1e-30f)); acc[ai][bj][m][1][j] *= g1[4 + j] * __builtin_amdgcn_rcpf(fmaxf(g2[4 + j], 1e-30f)); } } }
    }
    __device__ __forceinline__ void operator()(AccRef acc, const Unit& u, int wr, int wc, int fr, int fq) const {
        const int row0 = u.pm * 256 + wr * 64 + fr, cl = u.pn * 256 + wc * 32 + 8 * fq;
#pragma unroll
        for (int ai = 0; ai < 2; ++ai) { u32x4 w2[4][2];
            __builtin_amdgcn_sched_barrier(0);
#pragma unroll
            for (int m = 0; m < 4; ++m)
#pragma unroll
                for (int bj = 0; bj < 2; ++bj) w2[m][bj] = *(const u32x4*)(g + (size_t)(row0 + ai * 128 + m * 16) * 4096 + 2048 + cl + bj * 128);
            __builtin_amdgcn_sched_barrier(0);
#pragma unroll
            for (int m = 0; m < 4; ++m) { const int row = row0 + ai * 128 + m * 16;
#pragma unroll
                for (int bj = 0; bj < 2; ++bj) { EPI_GET8(v); const int gc = cl + bj * 128; float g2[8]; unpack8(w2[m][bj], g2);
#pragma unroll
                    for (int j = 0; j < 8; ++j) v[j] *= g2[j];
                    *(u32x4*)(merged + (size_t)row * 2048 + gc) = pack8(v); } } }
    }
};
struct EpiOut {
    static constexpr bool PERM = true, MID = false;
    bf16_t* o;
    __device__ __forceinline__ void operator()(AccRef acc, const Unit& u, int wr, int wc, int fr, int fq) const {
        const int row0 = u.pm * 256 + wr * 64 + fr, cl = u.pn * 256 + wc * 32 + 8 * fq;
        EPI_LOOP_ROWS { __builtin_amdgcn_sched_barrier(0); const int row = row0 + ai * 128 + m * 16;
#pragma unroll
            for (int bj = 0; bj < 2; ++bj) { EPI_GET8(v); *(u32x4*)(o + (size_t)row * 2048 + cl + bj * 128) = pack8(v); } }
    }
};

namespace att {
constexpr int NW = 8, QBLK = 32, KVBLK = 64;
constexpr float SCALE = 0.07216878364870322f;
constexpr float THR = 8.f;
constexpr int LDQ = 1536, LDK = 2048, LDR = 64, LDO = 2048;
constexpr size_t SHM_V = KVBLK * 128 * 2, SHM_K = KVBLK * 128 * 2, SHM_R = KVBLK * 64 * 2;
#define KSWZ(row, colB) ((row) * 256 + ((colB) ^ (((row) & 7) << 4)))
#define RSWZ(row, colB) ((row) * 128 + ((colB) ^ ((((row) >> 1) & 7) << 4)))
#define SBAR() __builtin_amdgcn_sched_barrier(0)
__device__ __forceinline__ int crow(int r, int hi) { return (r & 3) + 8 * (r >> 2) + 4 * hi; }
__device__ __forceinline__ void partialSM(f32x16& p0, f32x16& p1, float& m_reg, float& mn, float& alpha) {
    constexpr float C = SCALE * 1.4426950408889634f;
    float pmax = p0[0];
#pragma unroll
    for (int r = 1; r < 16; ++r) pmax = fmaxf(pmax, p0[r]);
#pragma unroll
    for (int r = 0; r < 16; ++r) pmax = fmaxf(pmax, p1[r]);
    { auto rr = __builtin_amdgcn_permlane32_swap(__float_as_uint(pmax), __float_as_uint(pmax), false, false); pmax = fmaxf(__uint_as_float(rr[0]), __uint_as_float(rr[1])); }
    if (__builtin_expect(__all(pmax - m_reg <= THR / SCALE), 1)) { mn = m_reg; alpha = 1.f; }
    else { mn = fmaxf(m_reg, pmax); alpha = __builtin_amdgcn_exp2f((m_reg - mn) * C); m_reg = mn; }
    const float mnC = -mn * C;
#pragma unroll
    for (int r = 0; r < 16; ++r) p0[r] = fmaf(p0[r], C, mnC);
#pragma unroll
    for (int r = 0; r < 16; ++r) p1[r] = fmaf(p1[r], C, mnC);
#pragma unroll
    for (int r = 0; r < 16; ++r) p0[r] = __builtin_amdgcn_exp2f(p0[r]);
}
__device__ __forceinline__ void finishSM(f32x16& p0, f32x16& p1, float alpha, float& l_reg, bf16x8& pa0, bf16x8& pa1, bf16x8& pa2, bf16x8& pa3) {
#pragma unroll
    for (int r = 0; r < 16; ++r) p1[r] = __builtin_amdgcn_exp2f(p1[r]);
    float ps = 0;
#pragma unroll
    for (int r = 0; r < 16; ++r) ps += p0[r];
#pragma unroll
    for (int r = 0; r < 16; ++r) ps += p1[r];
    { auto rr = __builtin_amdgcn_permlane32_swap(__float_as_uint(ps), __float_as_uint(ps), false, false); ps = __uint_as_float(rr[0]) + __uint_as_float(rr[1]); }
    l_reg = l_reg * alpha + ps;
#define PK4(P, BASE, OUT) do { unsigned a0 = cvt_pk_bf16(P[BASE + 0], P[BASE + 1]), a1 = cvt_pk_bf16(P[BASE + 2], P[BASE + 3]);   \
    unsigned b0 = cvt_pk_bf16(P[BASE + 4], P[BASE + 5]), b1 = cvt_pk_bf16(P[BASE + 6], P[BASE + 7]);                              \
    auto r0 = __builtin_amdgcn_permlane32_swap(a0, b0, false, false); auto r1 = __builtin_amdgcn_permlane32_swap(a1, b1, false, false); \
    u32x4 w = {r0[0], r1[0], r0[1], r1[1]}; OUT = *reinterpret_cast<bf16x8*>(&w); } while (0)
    PK4(p0, 0, pa0); PK4(p0, 8, pa1); PK4(p1, 0, pa2); PK4(p1, 8, pa3);
#undef PK4
}
__device__ __forceinline__ void qkt(f32x16& p0, f32x16& p1, const char* Ks, const char* Rs, const bf16x8* qr, const char* qrl, int r32, int hi) {
    p0 = f32x16{}; p1 = f32x16{};
#pragma unroll
    for (int d0 = 0; d0 < 8; ++d0) { const int cb = (d0 * 16 + hi * 8) * 2;
        const bf16x8 b0 = *reinterpret_cast<const bf16x8*>(Ks + KSWZ(r32, cb));
        const bf16x8 b1 = *reinterpret_cast<const bf16x8*>(Ks + KSWZ(32 + r32, cb));
        const bf16x8 qv = d0 < 6 ? qr[d0] : *reinterpret_cast<const bf16x8*>(qrl + (d0 - 6) * 1024);
        p0 = __builtin_amdgcn_mfma_f32_32x32x16_bf16(b0, qv, p0, 0, 0, 0);
        p1 = __builtin_amdgcn_mfma_f32_32x32x16_bf16(b1, qv, p1, 0, 0, 0); }
#pragma unroll
    for (int d0 = 0; d0 < 4; ++d0) { const int cb = (d0 * 16 + hi * 8) * 2;
        const bf16x8 b0 = *reinterpret_cast<const bf16x8*>(Rs + RSWZ(r32, cb));
        const bf16x8 b1 = *reinterpret_cast<const bf16x8*>(Rs + RSWZ(32 + r32, cb));
        const bf16x8 qv = *reinterpret_cast<const bf16x8*>(qrl + (2 + d0) * 1024);
        p0 = __builtin_amdgcn_mfma_f32_32x32x16_bf16(b0, qv, p0, 0, 0, 0);
        p1 = __builtin_amdgcn_mfma_f32_32x32x16_bf16(b1, qv, p1, 0, 0, 0); }
}
__device__ __forceinline__ int v_st(int k, int c) { const int kk = (k & ~0xC) | ((k & 4) << 1) | ((k & 8) >> 1); return ((kk >> 3) * 4 + (c >> 5)) * 512 + ((kk & 7) * 32 + (c & 31)) * 2; }
__device__ __forceinline__ int v_rd_base(int lane) { return ((lane & 3) << 3) | (((lane >> 2) & 3) << 6) | (((lane >> 4) & 1) << 5) | (((lane >> 5) & 1) << 8); }
constexpr int v_rd_off(int d0, int ks, int half) { return d0 * 512 + ks * 4096 + half * 2048; }
template <int OFF> __device__ __forceinline__ s16x4 tr_read(int vb) { s16x4 r; asm volatile("ds_read_b64_tr_b16 %0, %1 offset:%2" : "=&v"(r) : "v"(vb), "i"(OFF) : "memory"); return r; }
template <int D0> __device__ __forceinline__ void pv_one(f32x16& od, int vb, bf16x8 pa0, bf16x8 pa1, bf16x8 pa2, bf16x8 pa3) {
    const s16x4 l0 = tr_read<v_rd_off(D0, 0, 0)>(vb), h0 = tr_read<v_rd_off(D0, 0, 1)>(vb), l1 = tr_read<v_rd_off(D0, 1, 0)>(vb), h1 = tr_read<v_rd_off(D0, 1, 1)>(vb);
    const s16x4 l2 = tr_read<v_rd_off(D0, 2, 0)>(vb), h2 = tr_read<v_rd_off(D0, 2, 1)>(vb), l3 = tr_read<v_rd_off(D0, 3, 0)>(vb), h3 = tr_read<v_rd_off(D0, 3, 1)>(vb);
    asm volatile("s_waitcnt lgkmcnt(0)" ::: "memory"); SBAR();
#define PK(L, H) (bf16x8){L[0], L[1], L[2], L[3], H[0], H[1], H[2], H[3]}
    od = __builtin_amdgcn_mfma_f32_32x32x16_bf16(pa0, PK(l0, h0), od, 0, 0, 0);
    od = __builtin_amdgcn_mfma_f32_32x32x16_bf16(pa1, PK(l1, h1), od, 0, 0, 0);
    od = __builtin_amdgcn_mfma_f32_32x32x16_bf16(pa2, PK(l2, h2), od, 0, 0, 0);
    od = __builtin_amdgcn_mfma_f32_32x32x16_bf16(pa3, PK(l3, h3), od, 0, 0, 0);
#undef PK
}
__device__ __forceinline__ void pv_d0(f32x16* o, int vb, bf16x8 pa0, bf16x8 pa1, bf16x8 pa2, bf16x8 pa3) {
    pv_one<0>(o[0], vb, pa0, pa1, pa2, pa3); pv_one<1>(o[1], vb, pa0, pa1, pa2, pa3); pv_one<2>(o[2], vb, pa0, pa1, pa2, pa3); pv_one<3>(o[3], vb, pa0, pa1, pa2, pa3);
}
__device__ __forceinline__ void attn_body(const bf16_t* __restrict__ Qb, const bf16_t* __restrict__ Kh, const bf16_t* __restrict__ Vh, const bf16_t* __restrict__ Rh,
                                          bf16_t* __restrict__ Zb, int seq, char* lds, int tid_in) {
    int tid_l = tid_in; asm volatile("" : "+v"(tid_l));
    const int tid = tid_l, wid = tid >> 6, lane = tid & 63, r32 = lane & 31, hi = lane >> 5;
    char* V_lds = lds; char* K_lds = lds + 2 * SHM_V; char* R_lds = lds + 2 * SHM_V + 2 * SHM_K;
    float* wsf = (float*)(lds + 2 * SHM_V + 2 * SHM_K + 2 * SHM_R) + wid * 64; float* li_l = wsf; float* al_l = wsf + 32;
    float m_reg = -1e30f, l_reg = 0; f32x16 o[4] = {}; bf16x8 qr[6];
    char* qrl = lds + 2 * SHM_V + 2 * SHM_K + 2 * SHM_R + 2048 + wid * 6144 + lane * 16;
    const bf16_t* Qw = Qb + (long)(wid * QBLK + r32) * LDQ + hi * 8;
#pragma unroll
    for (int d0 = 0; d0 < 6; ++d0) qr[d0] = *reinterpret_cast<const bf16x8*>(Qw + d0 * 16);
    const int sr = tid >> 4, sc = (tid & 15) * 8, vst0 = v_st(sr, sc), vst1 = v_st(32 + sr, sc);
    const int rr_ = tid >> 3, rc_ = (tid & 7) * 8;
    const int vb0 = (int)(uintptr_t)V_lds + v_rd_base(lane);
    struct { bf16x8 vs0, vs1, ks0, ks1, rs; } sr_[1];
#define SLOAD(i, k0) do { sr_[i].vs0 = *(const bf16x8*)(&Vh[(long)((k0) + sr) * LDK + sc]); sr_[i].vs1 = *(const bf16x8*)(&Vh[(long)((k0) + 32 + sr) * LDK + sc]); \
    sr_[i].ks0 = *(const bf16x8*)(&Kh[(long)((k0) + sr) * LDK + sc]); sr_[i].ks1 = *(const bf16x8*)(&Kh[(long)((k0) + 32 + sr) * LDK + sc]); \
    sr_[i].rs = *(const bf16x8*)(&Rh[(long)((k0) + rr_) * LDR + rc_]); } while (0)
#define SWRITE(b, i) do { *(bf16x8*)(V_lds + (b) * SHM_V + vst0) = sr_[i].vs0; *(bf16x8*)(V_lds + (b) * SHM_V + vst1) = sr_[i].vs1; const int kc = sc * 2;  \
    *(bf16x8*)(K_lds + (b) * SHM_K + KSWZ(sr, kc)) = sr_[i].ks0; *(bf16x8*)(K_lds + (b) * SHM_K + KSWZ(32 + sr, kc)) = sr_[i].ks1; \
    *(bf16x8*)(R_lds + (b) * SHM_R + RSWZ(rr_, rc_ * 2)) = sr_[i].rs; } while (0)
#define SWAIT() asm volatile("s_waitcnt vmcnt(0)" ::: "memory")
#define RESC(a) do { if (__any((a) < 1.f)) { if (hi == 0) al_l[r32] = (a); asm volatile("s_waitcnt lgkmcnt(0)" ::: "memory"); \
    _Pragma("unroll") for (int d = 0; d < 4; ++d) _Pragma("unroll") for (int r = 0; r < 16; ++r) o[d][r] *= al_l[crow(r, hi)]; } } while (0)
    f32x16 pA0, pA1, pB0, pB1; float mnA, mnB, alA, alB; bf16x8 pa0, pa1, pa2, pa3; const int NT = seq / KVBLK;
    __syncthreads();
#pragma unroll
    for (int d0 = 0; d0 < 6; ++d0) *reinterpret_cast<bf16x8*>(qrl + d0 * 1024) = *reinterpret_cast<const bf16x8*>(Qw + 96 + d0 * 16);
    SLOAD(0, 0); asm volatile("s_waitcnt vmcnt(0)" ::: "memory"); SWRITE(0, 0); __syncthreads();
    qkt(pA0, pA1, K_lds, R_lds, qr, qrl, r32, hi); partialSM(pA0, pA1, m_reg, mnA, alA);
    SLOAD(0, KVBLK);
    SWAIT(); SWRITE(1, 0); __syncthreads();
    for (int j = 1; j + 1 < NT; j += 2) {
        SBAR(); qkt(pB0, pB1, K_lds + SHM_K, R_lds + SHM_R, qr, qrl, r32, hi);
        finishSM(pA0, pA1, alA, l_reg, pa0, pa1, pa2, pa3); SBAR();
        SLOAD(0, (j + 1) * KVBLK); SBAR();
        pv_d0(o, vb0, pa0, pa1, pa2, pa3); partialSM(pB0, pB1, m_reg, mnB, alB);
        __syncthreads(); SWAIT(); SWRITE(0, 0);
        RESC(alB); __syncthreads();
        SBAR(); qkt(pA0, pA1, K_lds, R_lds, qr, qrl, r32, hi);
        finishSM(pB0, pB1, alB, l_reg, pa0, pa1, pa2, pa3); SBAR();
        SLOAD(0, (j + 2) * KVBLK); SBAR();
        pv_d0(o, vb0 + (int)SHM_V, pa0, pa1, pa2, pa3); partialSM(pA0, pA1, m_reg, mnA, alA);
        __syncthreads(); SWAIT(); SWRITE(1, 0);
        RESC(alA); __syncthreads();
    }
    SBAR(); qkt(pB0, pB1, K_lds + SHM_K, R_lds + SHM_R, qr, qrl, r32, hi);
    finishSM(pA0, pA1, alA, l_reg, pa0, pa1, pa2, pa3); SBAR();
    pv_d0(o, vb0, pa0, pa1, pa2, pa3); partialSM(pB0, pB1, m_reg, mnB, alB);
    __syncthreads(); RESC(alB);
    finishSM(pB0, pB1, alB, l_reg, pa0, pa1, pa2, pa3); SBAR();
    pv_d0(o, vb0 + (int)SHM_V, pa0, pa1, pa2, pa3);
    if (hi == 0) li_l[r32] = l_reg;
    __syncthreads();
    { constexpr int SP = 272;
      char* stg = lds + wid * (32 * SP);
#pragma unroll
      for (int r = 0; r < 16; ++r) { const int orow = crow(r, hi); const float rli = __builtin_amdgcn_rcpf(li_l[orow]);
#pragma unroll
          for (int d0 = 0; d0 < 4; ++d0) *(bf16_t*)(stg + orow * SP + (d0 * 32 + r32) * 2) = f2bf(o[d0][r] * rli); }
      asm volatile("s_waitcnt lgkmcnt(0)" ::: "memory");
      bf16_t* Zw = Zb + (long)(wid * QBLK) * LDO;
      u32x4 zw[8];
#pragma unroll
      for (int i = 0; i < 8; ++i) { const int c = i * 64 + lane; zw[i] = *(const u32x4*)(Zw + (long)(c >> 4) * LDO + (c & 15) * 8); }
#pragma unroll
      for (int i = 0; i < 8; ++i) { const int c = i * 64 + lane, row = c >> 4, col8 = (c & 15) * 8;
          float ov[8], zv[8]; unpack8(*(const u32x4*)(stg + row * SP + col8 * 2), ov); unpack8(zw[i], zv);
#pragma unroll
          for (int e = 0; e < 8; ++e) ov[e] *= zv[e];
          *(u32x4*)(Zw + (long)row * LDO + col8) = pack8(ov); } }
#undef SLOAD
#undef SWRITE
#undef SWAIT
#undef RESC
}
}

__device__ __forceinline__ int map_col(int mode, int n) {
    if (mode == 1) {
        if (n < 1024) return n;
        if (n < 1536) { const int m = n - 1024; if (m < 64) return 1024 + (m >> 1) + 32 * (m & 1); if (m < 448) return 4096 + m; return -1; }
        if (n < 4608) return 1088 + (n - 1536);
        return n - 64;
    }
    if (mode == 2) { const int h = n / 192, c = n % 192; if (c < 128) return n; const int m = c - 128; return h * 192 + 128 + (m >> 1) + 32 * (m & 1); }
    return n;
}
__device__ __forceinline__ void transpose_tile(const float* src, int lds_, int K, bf16_t* dst, int mode, const float* scale, int tile, float* tl, int tid, int ldd = 0) {
    if (ldd == 0) ldd = K;
    const int nkb = K / 64, nb = tile / nkb, kb = tile % nkb, n0 = nb * 64, k0 = kb * 64;
    const int s0 = map_col(mode, n0), s63 = map_col(mode, n0 + 63);
    __syncthreads();
    if ((s0 >= 0 && s63 == s0 + 63 && map_col(mode, n0 + 1) == s0 + 1) || (s0 < 0 && s63 < 0)) {
        const int n4 = (tid & 15) * 4;
#pragma unroll
        for (int it = 0; it < 2; ++it) { const int kk = (tid >> 4) + 32 * it; f32x4 v = s0 >= 0 ? *(const f32x4*)(src + (size_t)(k0 + kk) * lds_ + s0 + n4) : (f32x4){0.f, 0.f, 0.f, 0.f};
            if (scale) v = v * scale[k0 + kk];
            tl[kk * 65 + n4 + 0] = v[0]; tl[kk * 65 + n4 + 1] = v[1]; tl[kk * 65 + n4 + 2] = v[2]; tl[kk * 65 + n4 + 3] = v[3]; }
    } else {
        const int nn = tid & 63, sc = map_col(mode, n0 + nn);
#pragma unroll
        for (int it = 0; it < 8; ++it) { const int kk = (tid >> 6) + 8 * it; float v = sc >= 0 ? src[(size_t)(k0 + kk) * lds_ + sc] : 0.f; if (scale) v *= scale[k0 + kk]; tl[kk * 65 + nn] = v; }
    }
    __syncthreads();
    const int nr = tid >> 3, kc = (tid & 7) * 8; float v[8];
#pragma unroll
    for (int e = 0; e < 8; ++e) v[e] = tl[(kc + e) * 65 + nr];
    *(u32x4*)(dst + (size_t)(n0 + nr) * ldd + k0 + kc) = pack8(v);
}

constexpr int SC_C = 32;
struct ScanOps { f32x4 w0, w1, a0, a1, b0, b1, k0, k1, r0, r1; float v; };
__device__ __forceinline__ void scan_chain(const Params& p, int c, char* lds, int tid_in) {
    const bf16_t* rkv = (const bf16_t*)(p.ws + WS_RKV); const unsigned short* ua = (const unsigned short*)(p.ws + WS_UA);
    const int dir = c >> 7, b = (c >> 4) & 7, h = c & 15;
    float* yout = (float*)(p.ws + (dir ? WS_YB : WS_YF));
    int tid_l = tid_in; asm volatile("" : "+v"(tid_l));
    const int tid = tid_l, wid = tid >> 6, lane = tid & 63, row = tid >> 3, sub = tid & 7;
    float* L = (float*)lds;
    float* ybuf = L + 2 * 6 * SC_C * 64;
    const int psl = tid >> 4, pc4 = (tid & 15) * 4, ch = h * 64 + pc4;
    const f32x4 mu_r = *(const f32x4*)(p.mu + ch), mu_k = *(const f32x4*)(p.mu + 1024 + ch), mu_v = *(const f32x4*)(p.mu + 2048 + ch), kk_c = *(const f32x4*)(p.k_k + ch), ka_c = *(const f32x4*)(p.k_a + ch);
    f32x2 s01 = {0.f, 0.f}, s23 = {0.f, 0.f}, s45 = {0.f, 0.f}, s67 = {0.f, 0.f};
    u32x2 raw[3][3], raw_u, raw_a;
    const size_t tok0 = (size_t)b * SEQ;
#define SC_LOAD(chunk) do { const int st = (chunk) * SC_C + psl; const int t = dir ? (SEQ - 1 - st) : st; \
        const bf16_t* base = rkv + (tok0 + t) * 3072 + ch; const bool hm = t > 0, hp = t < SEQ - 1; \
        _Pragma("unroll") for (int sg = 0; sg < 3; ++sg) { raw[sg][1] = *(const u32x2*)(base + sg * 1024); \
            raw[sg][0] = hm ? *(const u32x2*)(base + sg * 1024 - 3072) : (u32x2){0u, 0u}; raw[sg][2] = hp ? *(const u32x2*)(base + sg * 1024 + 3072) : (u32x2){0u, 0u}; } \
        const unsigned short* ub = ua + (tok0 + t) * 4096 + dir * 1024 + ch; raw_u = *(const u32x2*)ub; raw_a = *(const u32x2*)(ub + 2048); } while (0)
#define SC_PREP(bufi) do { float* Lb = L + (bufi) * 6 * SC_C * 64 + psl * 64 + pc4; float rr[3][3][4]; \
        _Pragma("unroll") for (int sg = 0; sg < 3; ++sg) _Pragma("unroll") for (int d = 0; d < 3; ++d) unpack4(raw[sg][d], rr[sg][d]); \
        float uu[4], aa[4]; unpack4h(raw_u, uu); unpack4h(raw_a, aa); f32x4 r4, k4, v4, kk4; float n2 = 0.f; \
        _Pragma("unroll") for (int e = 0; e < 4; ++e) { r4[e] = rr[0][1][e] + mu_r[e] * (0.5f * (rr[0][0][e] + rr[0][2][e]) - rr[0][1][e]); k4[e] = rr[1][1][e] + mu_k[e] * (0.5f * (rr[1][0][e] + rr[1][2][e]) - rr[1][1][e]); \
            v4[e] = rr[2][1][e] + mu_v[e] * (0.5f * (rr[2][0][e] + rr[2][2][e]) - rr[2][1][e]); kk4[e] = k4[e] * kk_c[e]; n2 += kk4[e] * kk4[e]; } \
        const float rn = __builtin_amdgcn_rsqf(fmaxf(red16(n2), 1e-24f)); f32x4 w4, na4, b4, kf4; \
        _Pragma("unroll") for (int e = 0; e < 4; ++e) { const float kk = kk4[e] * rn; w4[e] = __expf(-0.6065306597126334f * uu[e]); na4[e] = -kk; b4[e] = kk * aa[e]; kf4[e] = k4[e] * (1.f + (aa[e] - 1.f) * ka_c[e]); } \
        *(f32x4*)(Lb + 0 * SC_C * 64) = w4; *(f32x4*)(Lb + 1 * SC_C * 64) = na4; *(f32x4*)(Lb + 2 * SC_C * 64) = b4; *(f32x4*)(Lb + 3 * SC_C * 64) = kf4; *(f32x4*)(Lb + 4 * SC_C * 64) = r4; *(f32x4*)(Lb + 5 * SC_C * 64) = v4; } while (0)
#define SC_FLUSH(chunk) do { const float* yb = ybuf + ((chunk) & 1) * SC_C * 64; const int sl = tid >> 4, i4 = (tid & 15) * 4; const int st = (chunk) * SC_C + sl; const int t = dir ? (SEQ - 1 - st) : st; \
        *(f32x4*)(yout + (tok0 + t) * 1024 + h * 64 + i4) = *(const f32x4*)(yb + sl * 64 + i4); } while (0)
    constexpr int NCH = SEQ / SC_C;
    __syncthreads();
    SC_LOAD(0); SC_PREP(0); __syncthreads();
    for (int n = 0; n < NCH; ++n) {
        if (n + 1 < NCH) SC_LOAD(n + 1);
        if (n > 0) SC_FLUSH(n - 1);
        const float* Lb = L + (n & 1) * 6 * SC_C * 64 + sub * 8; float* yb = ybuf + (n & 1) * SC_C * 64;
        const float* Lv = L + (n & 1) * 6 * SC_C * 64 + 5 * SC_C * 64 + row;
#define SC_LDA(O, sl) do { O.w0 = *(const f32x4*)(Lb + (0 * SC_C + (sl)) * 64); O.w1 = *(const f32x4*)(Lb + (0 * SC_C + (sl)) * 64 + 4); O.a0 = *(const f32x4*)(Lb + (1 * SC_C + (sl)) * 64); O.a1 = *(const f32x4*)(Lb + (1 * SC_C + (sl)) * 64 + 4); \
        O.b0 = *(const f32x4*)(Lb + (2 * SC_C + (sl)) * 64); O.b1 = *(const f32x4*)(Lb + (2 * SC_C + (sl)) * 64 + 4); } while (0)
#define SC_LDB(O, sl) do { O.k0 = *(const f32x4*)(Lb + (3 * SC_C + (sl)) * 64); O.k1 = *(const f32x4*)(Lb + (3 * SC_C + (sl)) * 64 + 4); \
        O.r0 = *(const f32x4*)(Lb + (4 * SC_C + (sl)) * 64); O.r1 = *(const f32x4*)(Lb + (4 * SC_C + (sl)) * 64 + 4); O.v = Lv[(sl) * 64]; } while (0)
#define SC_LD(O, sl) do { SC_LDA(O, sl); SC_LDB(O, sl); } while (0)
#define LO2(x) __builtin_shufflevector(x, x, 0, 1)
#define HI2(x) __builtin_shufflevector(x, x, 2, 3)
        ScanOps o0, o1, o2; SC_LD(o0, 0); SC_LD(o1, 1);
        float ysel = 0.f, ypend = 0.f;
#define SC_STEP(cur, ld, u) do { \
              \
            if ((u) + 2 < SC_C) SC_LD(ld, (u) + 2); \
            f32x2 acc = s01 * LO2(cur.a0); acc = __builtin_elementwise_fma(s23, HI2(cur.a0), acc); acc = __builtin_elementwise_fma(s45, LO2(cur.a1), acc); acc = __builtin_elementwise_fma(s67, HI2(cur.a1), acc); \
            float t_ = acc.x + acc.y; \
            t_ += dppx<0xB1>(t_); ypend += dppx<0xB1>(ypend); t_ += dppx<0x4E>(t_); ypend += dppx<0x4E>(ypend); t_ += dppx<0x141>(t_); ypend += dppx<0x141>(ypend); \
            const float sa = t_; \
            if ((u) > 0) { ysel = (sub == (((u) - 1) & 7)) ? ypend : ysel; if ((((u) - 1) & 7) == 7) yb[((u) - 8 + sub) * 64 + row] = ysel; } \
            const f32x2 sa2 = {sa, sa}, vi2 = {cur.v, cur.v}; \
            s01 = __builtin_elementwise_fma(LO2(cur.k0), vi2, __builtin_elementwise_fma(LO2(cur.b0), sa2, s01 * LO2(cur.w0))); \
            s23 = __builtin_elementwise_fma(HI2(cur.k0), vi2, __builtin_elementwise_fma(HI2(cur.b0), sa2, s23 * HI2(cur.w0))); \
            s45 = __builtin_elementwise_fma(LO2(cur.k1), vi2, __builtin_elementwise_fma(LO2(cur.b1), sa2, s45 * LO2(cur.w1))); \
            s67 = __builtin_elementwise_fma(HI2(cur.k1), vi2, __builtin_elementwise_fma(HI2(cur.b1), sa2, s67 * HI2(cur.w1))); \
            f32x2 yy = s01 * LO2(cur.r0); yy = __builtin_elementwise_fma(s23, HI2(cur.r0), yy); yy = __builtin_elementwise_fma(s45, LO2(cur.r1), yy); yy = __builtin_elementwise_fma(s67, HI2(cur.r1), yy); \
            ypend = yy.x + yy.y; \
            if ((u) + 2 < SC_C) { _Pragma("unroll") for (int g_ = 0; g_ < 11; ++g_) { __builtin_amdgcn_sched_group_barrier(0x002, 3, 0); __builtin_amdgcn_sched_group_barrier(0x100, 1, 0); } } \
            __builtin_amdgcn_sched_barrier(0); } while (0)
#define SC_STEP3(u) SC_STEP(o0, o2, u); SC_STEP(o1, o0, (u) + 1); SC_STEP(o2, o1, (u) + 2)
        SC_STEP3(0); SC_STEP3(3); SC_STEP3(6); SC_STEP3(9); SC_STEP3(12); SC_STEP3(15); SC_STEP3(18); SC_STEP3(21); SC_STEP3(24); SC_STEP3(27);
        SC_STEP(o0, o2, 30); SC_STEP(o1, o0, 31);
        { const float yl = red8(ypend); ysel = (sub == 7) ? yl : ysel; yb[(24 + sub) * 64 + row] = ysel; }
#undef SC_STEP3
#undef SC_STEP
#undef SC_LD
#undef SC_LDA
#undef SC_LDB
#undef LO2
#undef HI2
        if (n + 1 < NCH) SC_PREP((n + 1) & 1);
        __syncthreads();
    }
    SC_FLUSH(NCH - 1);
#undef SC_LOAD
#undef SC_PREP
#undef SC_FLUSH
}

struct P5In { f32x4 yf[2], yb[2]; u32x4 r[3][3]; u32x4 af, ab, z; };
__device__ __forceinline__ void unpack8h(u32x4 w, float* v) { v[0] = h2f((unsigned short)(w.x & 0xffffu)); v[1] = h2f((unsigned short)(w.x >> 16)); v[2] = h2f((unsigned short)(w.y & 0xffffu)); v[3] = h2f((unsigned short)(w.y >> 16));
    v[4] = h2f((unsigned short)(w.z & 0xffffu)); v[5] = h2f((unsigned short)(w.z >> 16)); v[6] = h2f((unsigned short)(w.w & 0xffffu)); v[7] = h2f((unsigned short)(w.w >> 16)); }
__device__ __forceinline__ void p5_load(P5In& in, int it, int c8, const float* __restrict__ yf, const float* __restrict__ yb, const bf16_t* __restrict__ rkv, const unsigned short* __restrict__ ua, const bf16_t* zb) {
    const int row = it >> 1, ch = (it & 1) * 512 + c8, t = row & (SEQ - 1);
    const float* yfp = yf + (size_t)row * 1024 + ch; const float* ybp = yb + (size_t)row * 1024 + ch;
    in.yf[0] = *(const f32x4*)yfp; in.yf[1] = *(const f32x4*)(yfp + 4); in.yb[0] = *(const f32x4*)ybp; in.yb[1] = *(const f32x4*)(ybp + 4);
    const bf16_t* base = rkv + (size_t)row * 3072 + ch; const bool hm = t > 0, hp = t < SEQ - 1;
#pragma unroll
    for (int sg = 0; sg < 3; ++sg) { in.r[sg][1] = *(const u32x4*)(base + sg * 1024);
        in.r[sg][0] = hm ? *(const u32x4*)(base + sg * 1024 - 3072) : (u32x4){0u, 0u, 0u, 0u}; in.r[sg][2] = hp ? *(const u32x4*)(base + sg * 1024 + 3072) : (u32x4){0u, 0u, 0u, 0u}; }
    const unsigned short* ub = ua + (size_t)row * 4096 + 2048 + ch; in.af = *(const u32x4*)ub; in.ab = *(const u32x4*)(ub + 1024);
    in.z = *(const u32x4*)(zb + (size_t)row * 2048 + 1024 + ch);
}
struct P5Par { float mur[8], muk[8], muv[8], ka[8], rk[8], gg[8], gb[8]; };
__device__ __forceinline__ void p5_finish(const P5In& in, int it, int c8, const P5Par& pp, bf16_t* zb) {
    const int row = it >> 1, ch = (it & 1) * 512 + c8;
    float y[8], sy = 0.f;
#pragma unroll
    for (int e = 0; e < 8; ++e) { y[e] = in.yf[e >> 2][e & 3] + in.yb[e >> 2][e & 3]; sy += y[e]; }
    const float mean = red8(sy) * (1.f / 64.f); float sv = 0.f;
#pragma unroll
    for (int e = 0; e < 8; ++e) { y[e] -= mean; sv += y[e] * y[e]; }
    const float rstd = rsqrtf(red8(sv) * (1.f / 64.f) + 64e-5f);
    float rr[3][3][8];
#pragma unroll
    for (int sg = 0; sg < 3; ++sg)
#pragma unroll
        for (int d = 0; d < 3; ++d) unpack8(in.r[sg][d], rr[sg][d]);
    float af[8], ab[8], zz[8], vv[8], sb = 0.f; unpack8h(in.af, af); unpack8h(in.ab, ab); unpack8(in.z, zz);
#pragma unroll
    for (int e = 0; e < 8; ++e) { const float r = rr[0][1][e] + pp.mur[e] * (0.5f * (rr[0][0][e] + rr[0][2][e]) - rr[0][1][e]), k = rr[1][1][e] + pp.muk[e] * (0.5f * (rr[1][0][e] + rr[1][2][e]) - rr[1][1][e]);
        vv[e] = rr[2][1][e] + pp.muv[e] * (0.5f * (rr[2][0][e] + rr[2][2][e]) - rr[2][1][e]);
        sb += r * (k * (2.f + (af[e] + ab[e] - 2.f) * pp.ka[e])) * pp.rk[e]; }
    const float bon = red8(sb);
    float o[8];
#pragma unroll
    for (int e = 0; e < 8; ++e) o[e] = (y[e] * rstd * pp.gg[e] + pp.gb[e] + bon * vv[e]) * zz[e];
    *(u32x4*)(zb + (size_t)row * 2048 + 1024 + ch) = pack8(o);
}

constexpr int T_IN = (NP1 / 64) * 32, T_Q = 24 * 8, T_KV = 32 * 8, T_BM = 32 * 16, T_OUT = 32 * 32, T_REST = T_Q + T_KV + 2 * T_BM + T_OUT;
constexpr int LDS_PHASE_BYTES = 139264;
#define XB_TMO      128
#define XB_XCNT(j)  (256  + 64 * (j))
#define XB_XSUB(j)  (1280 + 64 * (j))
#define XB_XGEN(j)  (2304 + 64 * (j))
#define XB_TOP      3328
#define XB_TOPGEN   3392
#define XCD_BAR_WORDS 3456
#define XB_SPIN_CAP (1u << 20)
__device__ __forceinline__ unsigned xb_ld(unsigned* p)              { return __hip_atomic_load(p, __ATOMIC_RELAXED, __HIP_MEMORY_SCOPE_AGENT); }
__device__ __forceinline__ unsigned xb_add(unsigned* p, unsigned v) { return __hip_atomic_fetch_add(p, v, __ATOMIC_RELAXED, __HIP_MEMORY_SCOPE_AGENT); }
__device__ __forceinline__ unsigned xb_xcc_id() { return (unsigned)__builtin_amdgcn_s_getreg((3 << 11) | 20) & 0xFu; }
#define XB_SPIN(cond, bar) do { unsigned _sp = 0; while (cond) { __builtin_amdgcn_s_sleep(1); \
    if ((++_sp & 255u) == 0u) { if (xb_ld(&(bar)[XB_TMO])) break; if (_sp > XB_SPIN_CAP) { atomicAdd(&(bar)[XB_TMO], 1u); break; } } } } while (0)
__device__ __forceinline__ void xcd_barrier_complete(unsigned* bar, unsigned x, unsigned G, unsigned& nloc, unsigned& nx) {
    unsigned sum, cnt, mine, sp = 0u;
    for (;;) {
        sum = 0u; cnt = 0u; mine = 0u;
#pragma unroll
        for (unsigned j = 0; j < 16; ++j) { const unsigned c = xb_ld(&bar[XB_XCNT(j)]); sum += c; cnt += (c > 0u) ? 1u : 0u; mine = (j == x) ? c : mine; }
        if (sum == G) break;
        __builtin_amdgcn_s_sleep(1);
        if ((++sp & 255u) == 0u) { if (xb_ld(&bar[XB_TMO])) break; if (sp > XB_SPIN_CAP) { atomicAdd(&bar[XB_TMO], 1u); break; } }
    }
    nloc = mine > 0u ? mine : 1u; nx = cnt > 0u ? cnt : 1u;
}
__device__ __forceinline__ void grid_barrier(unsigned* bar, volatile __attribute__((address_space(3))) unsigned* st, unsigned G, int tid) {
    asm volatile("s_waitcnt vmcnt(0)" ::: "memory");
    __syncthreads();
    if (tid == 0) {
        __builtin_amdgcn_s_waitcnt(0);
        const unsigned x = xb_xcc_id();
        unsigned nloc = st[0], nx = st[1];
        if (nloc == 0u) { xcd_barrier_complete(bar, x, G, nloc, nx); st[0] = nloc; st[1] = nx; }
        const unsigned old = xb_add(&bar[XB_XSUB(x)], 1u);
        const unsigned gen = old / nloc;
        if (old + 1u == (gen + 1u) * nloc) {
            __builtin_amdgcn_fence(__ATOMIC_RELEASE, "agent");
            asm volatile("s_waitcnt vmcnt(0)" ::: "memory");
            const unsigned og = xb_add(&bar[XB_TOP], 1u);
            const unsigned tg = og / nx;
            if (og + 1u == (tg + 1u) * nx) xb_add(&bar[XB_TOPGEN], 1u);
            else XB_SPIN(xb_ld(&bar[XB_TOPGEN]) == tg, bar);
            __builtin_amdgcn_fence(__ATOMIC_ACQUIRE, "agent");
            xb_add(&bar[XB_XGEN(x)], 1u);
            asm volatile("s_waitcnt vmcnt(0)" ::: "memory");
        } else {
            XB_SPIN(xb_ld(&bar[XB_XGEN(x)]) == gen, bar);
            __builtin_amdgcn_fence(__ATOMIC_ACQUIRE, "agent");
            asm volatile("s_waitcnt vmcnt(0)" ::: "memory");
        }
    }
    __syncthreads();
}
typedef const __attribute__((address_space(4))) Params* KP;
__device__ __forceinline__ Params load_params(KP kp) {
#if defined(__HIP_DEVICE_COMPILE__)
    return *kp;
#else
    return Params{};
#endif
}
#define PH_HEADER() \
        KP kp = (KP)__builtin_amdgcn_kernarg_segment_ptr(); asm volatile("" : "+s"(kp)); Params p = load_params(kp); \
         \
        unsigned char* ws = p.ws; asm volatile("" : "+s"(ws)); int tid = wid_s * 64 + (int)__builtin_amdgcn_mbcnt_hi(~0u, __builtin_amdgcn_mbcnt_lo(~0u, 0u)); asm volatile("" : "+v"(tid)); \
        const int wid = tid >> 6, lane = tid & 63, gw = bid * 8 + wid, NGW = G * 8; \
        bf16_t* W_in = (bf16_t*)(ws + WS_WIN); bf16_t* W_q = (bf16_t*)(ws + WS_WQ); bf16_t* W_kv = (bf16_t*)(ws + WS_WKV); bf16_t* W_lw = (bf16_t*)(ws + WS_LW); bf16_t* W_la = (bf16_t*)(ws + WS_LA); \
        bf16_t* W_bm = (bf16_t*)(ws + WS_WBM); bf16_t* W_br = (bf16_t*)(ws + WS_WBR); bf16_t* W_out = (bf16_t*)(ws + WS_WOUT); \
        float* cs = (float*)(ws + WS_CS); float* ssq = (float*)(ws + WS_SSQ); \
        bf16_t* hbuf = (bf16_t*)(ws + WS_H); bf16_t* qa = (bf16_t*)(ws + WS_QA); bf16_t* kva = (bf16_t*)(ws + WS_KVA); bf16_t* misc = (bf16_t*)(ws + WS_MISC); bf16_t* krope = (bf16_t*)(ws + WS_KROPE); \
        bf16_t* rkv = (bf16_t*)(ws + WS_RKV); bf16_t* zb = (bf16_t*)(ws + WS_Z); bf16_t* gb = (bf16_t*)p.out; bf16_t* qb = (bf16_t*)(ws + WS_Q); bf16_t* kvb = (bf16_t*)(ws + WS_KV); \
        bf16_t* Aw = (bf16_t*)(ws + WS_AW); bf16_t* Aa = (bf16_t*)(ws + WS_AA); unsigned short* ua = (unsigned short*)(ws + WS_UA); \
        float* tmp = (float*)(ws + WS_TMP); bf16_t* merged = (bf16_t*)(ws + WS_MERGED); \
        PG8_LAS unsigned char* glds = (PG8_LAS unsigned char*)shm; \
        pg8::StaticOrder S;
__global__ void __launch_bounds__(512) hybrid_fwd(Params p_arg) {
    extern __shared__ __attribute__((aligned(16))) char shm[];
    cg::grid_group grid = cg::this_grid();
    const int G = gridDim.x, bid = blockIdx.x;
    const int wid_s = __builtin_amdgcn_readfirstlane((int)threadIdx.x >> 6);
    const int ph_lo = p_arg.ph_lo, ph_hi = p_arg.ph_hi;
    volatile __attribute__((address_space(3))) unsigned* xb_st = (volatile __attribute__((address_space(3))) unsigned*)(shm + LDS_PHASE_BYTES);
    if (ph_hi - ph_lo > 1) {
        if (threadIdx.x == 0) { xb_st[0] = 0u; xb_st[1] = 0u; (void)xb_add((unsigned*)(p_arg.ws + WS_BAR) + XB_XCNT(xb_xcc_id()), 1u); }
        grid.sync();
    }
        if (PHEN(0) && ph_lo <= 0 && 0 < ph_hi) { PH_HEADER();
        for (int rep_ = 0; rep_ < DBLN(0); ++rep_) {
            for (int it = bid; it < T_IN; it += G) transpose_tile(p.w_in, DIN, 2048, W_in, 1, nullptr, it, (float*)shm, tid);
            for (int i = bid * 512 + tid; i < 2 * 2048 * 32; i += G * 512) { const int which = i >> 16, rem = i & 65535, kg = rem >> 11, n = rem & 2047, k0 = kg * 8;
                float v[8] = {0.f, 0.f, 0.f, 0.f, 0.f, 0.f, 0.f, 0.f}; const float* sp = nullptr;
                if (n < 1024) { if (k0 < 96) sp = (which ? p.a2_f : p.w2_f) + (size_t)k0 * 1024 + n; } else { if (k0 >= 128 && k0 < 224) sp = (which ? p.a2_b : p.w2_b) + (size_t)(k0 - 128) * 1024 + (n - 1024); }
                if (sp) {
#pragma unroll
                    for (int e = 0; e < 8; ++e) v[e] = sp[(size_t)e * 1024]; }
                *(u32x4*)((which ? W_la : W_lw) + (size_t)n * 256 + k0) = pack8(v); }
            for (int i = bid * 512 + tid; i < SEQ * 32; i += G * 512) { const int pos = i >> 5, fi = i & 31; const float inv = exp2f(-(float)fi * (13.287712379549449f / 32.f)); const float ang = (float)pos * inv;
                double rev = (double)ang * 0.15915494309189535; rev -= floor(rev); const float rf = (float)rev;
                cs[2 * i] = __builtin_amdgcn_cosf(rf); cs[2 * i + 1] = __builtin_amdgcn_sinf(rf); }
            f32x4 gpre[4][2];
#pragma unroll
            for (int j = 0; j < 4; ++j)
#pragma unroll
                for (int hh = 0; hh < 2; ++hh) gpre[j][hh] = *(const f32x4*)(p.g_pre + (j * 64 + lane) * 8 + hh * 4);
            for (int row = gw; row < T; row += NGW) { const float* xr = p.x + (size_t)row * DM; f32x4 v[4][2]; float s = 0.f;
#pragma unroll
                for (int j = 0; j < 4; ++j)
#pragma unroll
                    for (int hh = 0; hh < 2; ++hh) { v[j][hh] = *(const f32x4*)(xr + (j * 64 + lane) * 8 + hh * 4); s += (v[j][hh][0] * v[j][hh][0] + v[j][hh][1] * v[j][hh][1]) + (v[j][hh][2] * v[j][hh][2] + v[j][hh][3] * v[j][hh][3]); }
                const float rs = rsqrtf(wave_sum_fast(s) * (1.f / DM) + 1e-6f);
#pragma unroll
                for (int j = 0; j < 4; ++j) { float o[8];
#pragma unroll
                    for (int e = 0; e < 4; ++e) { o[e] = v[j][0][e] * rs * gpre[j][0][e]; o[4 + e] = v[j][1][e] * rs * gpre[j][1][e]; }
                    *(u32x4*)(hbuf + (size_t)row * DM + (j * 64 + lane) * 8) = pack8(o); } }

        } }
        if (PHEN(1) && ph_lo <= 1 && 1 < ph_hi) { PH_HEADER(); if (1 > ph_lo) grid_barrier((unsigned*)(ws + WS_BAR), xb_st, (unsigned)G, tid);
        for (int rep_ = 0; rep_ < DBLN(1); ++rep_) {
            S.init(T, NP1, G, bid); Epi1 E{qa, kva, misc, krope, rkv, zb, gb, ssq, cs};
            pg8::gemm_phase(glds, pg8::Gemm{hbuf, W_in, T, NP1, 2048, 2048, 2048}, S, E, tid);
            if (bid >= G / 2) for (int it = bid - G / 2; it < T_REST; it += G - G / 2) { int r = it; float* tl = (float*)shm;
                if (r < T_Q) { transpose_tile(p.wq_b, 1536, 512, W_q, 2, p.q_norm, r, tl, tid); continue; } r -= T_Q;
                if (r < T_KV) { transpose_tile(p.wkv_b, 2048, 512, W_kv, 0, p.kv_norm, r, tl, tid); continue; } r -= T_KV;
                if (r < T_BM) { transpose_tile(p.w_br_mla, 2048, 1024, W_bm, 0, nullptr, r, tl, tid, 2048); continue; } r -= T_BM;
                if (r < T_BM) { transpose_tile(p.w_br_rwkv, 2048, 1024, W_bm + 1024, 0, nullptr, r, tl, tid, 2048); continue; } r -= T_BM;
                transpose_tile(p.w_out, 2048, 2048, W_out, 0, nullptr, r, tl, tid); }

        } }
        if (PHEN(2) && ph_lo <= 2 && 2 < ph_hi) { PH_HEADER(); if (2 > ph_lo) grid_barrier((unsigned*)(ws + WS_BAR), xb_st, (unsigned)G, tid);
        for (int rep_ = 0; rep_ < DBLN(2); ++rep_) {
            { S.init(T, 1536, G, bid); EpiQ E{qb, ssq, cs}; pg8::gemm_phase(glds, pg8::Gemm{qa, W_q, T, 1536, 512, 512, 512}, S, E, tid); }
            { S.init(T, 2048, G, bid); EpiKV E{kvb, ssq}; pg8::gemm_phase(glds, pg8::Gemm{kva, W_kv, T, 2048, 512, 512, 512}, S, E, tid); }
            { const int c = tid & 63, isA = c >> 5, cc = (c & 31) * 8, half = cc >> 7, kc = cc & 127;
              const bool live = kc < 96; const int mcol = 64 + isA * 192 + half * 96 + kc;
              float mu8[8];
#pragma unroll
              for (int e = 0; e < 8; ++e) mu8[e] = live ? p.mu[3072 + isA * 192 + half * 96 + kc + e] : 0.f;
              bf16_t* dstb = (isA ? Aa : Aw) + cc;
              for (int row = bid * 8 + (tid >> 6); row < T; row += G * 8) { const int t = row & (SEQ - 1); u32x4 outv = {0u, 0u, 0u, 0u};
                  if (live) { const bf16_t* mp = misc + (size_t)row * 512 + mcol; float o[8], x0[8], xm[8], xp[8];
                      unpack8(*(const u32x4*)mp, x0); unpack8(t > 0 ? *(const u32x4*)(mp - 512) : (u32x4){0u, 0u, 0u, 0u}, xm); unpack8(t < SEQ - 1 ? *(const u32x4*)(mp + 512) : (u32x4){0u, 0u, 0u, 0u}, xp);
#pragma unroll
                      for (int e = 0; e < 8; ++e) { const float xs = x0[e] + mu8[e] * (0.5f * (xm[e] + xp[e]) - x0[e]); o[e] = isA ? xs : 1.f - 2.f * __builtin_amdgcn_rcpf(1.f + __expf(2.f * xs)); }
                      outv = pack8(o); }
                  *(u32x4*)(dstb + (size_t)row * 256) = outv; } }

        } }
        if (PHEN(3) && ph_lo <= 3 && 3 < ph_hi) { PH_HEADER(); if (3 > ph_lo) grid_barrier((unsigned*)(ws + WS_BAR), xb_st, (unsigned)G, tid);
            for (int i = 0; i * G + bid < 512; ++i) { const int L = i * G + bid; int b, h, qblk;
                if (G == 256) { const int xcd = bid & 7, sI = bid >> 3, idx = i * 32 + sI, pl = idx >> 3; qblk = idx & 7; const int pair = pl * 8 + xcd; b = pair >> 3; h = pair & 7; }
                else { qblk = L & 7; h = (L >> 3) & 7; b = L >> 6; }
                const size_t tok0 = (size_t)b * SEQ;
                att::attn_body(qb + (tok0 + qblk * 256) * 1536 + h * 192, kvb + tok0 * 2048 + h * 256, kvb + tok0 * 2048 + h * 256 + 128, krope + tok0 * 64,
                               zb + (tok0 + qblk * 256) * 2048 + h * 128, SEQ, shm, tid); }
            __syncthreads();
#ifndef NO_LORA
            { S.init(T, 2048, G, bid); EpiLora E{ua, 0, p.w0_f, p.w0_b}; pg8::gemm_phase(glds, pg8::Gemm{Aw, W_lw, T, 2048, 256, 256, 256}, S, E, tid); }
            { S.init(T, 2048, G, bid); EpiLora E{ua, 2048, p.a0_f, p.a0_b}; pg8::gemm_phase(glds, pg8::Gemm{Aa, W_la, T, 2048, 256, 256, 256}, S, E, tid); }
#endif
        }
        if (PHEN(4) && ph_lo <= 4 && 4 < ph_hi) { PH_HEADER(); if (4 > ph_lo) grid_barrier((unsigned*)(ws + WS_BAR), xb_st, (unsigned)G, tid);
        for (int rep_ = 0; rep_ < DBLN(4); ++rep_) {
            for (int c = bid; c < 256; c += G) scan_chain(p, c, shm, tid);

        } }
        if (PHEN(5) && ph_lo <= 5 && 5 < ph_hi) { PH_HEADER(); if (5 > ph_lo) grid_barrier((unsigned*)(ws + WS_BAR), xb_st, (unsigned)G, tid);
            const float* __restrict__ yf = (const float*)(ws + WS_YF); const float* __restrict__ yb = (const float*)(ws + WS_YB);
            const int c8 = lane * 8;
            P5Par pp; { const int chq = (gw & 1) * 512 + c8;
#pragma unroll
                for (int e = 0; e < 8; ++e) { pp.mur[e] = p.mu[chq + e]; pp.muk[e] = p.mu[1024 + chq + e]; pp.muv[e] = p.mu[2048 + chq + e]; pp.ka[e] = p.k_a[chq + e]; pp.rk[e] = p.r_k[chq + e]; pp.gg[e] = p.gn_g[chq + e]; pp.gb[e] = p.gn_b[chq + e]; } }
            for (int it0 = gw; it0 < T * 2; it0 += 2 * NGW) {
                P5In in[2];
#pragma unroll
                for (int k = 0; k < 2; ++k) { const int it = it0 + k * NGW; if (it < T * 2) p5_load(in[k], it, c8, yf, yb, rkv, ua, zb); }
#pragma unroll
                for (int k = 0; k < 2; ++k) { const int it = it0 + k * NGW; if (it < T * 2) p5_finish(in[k], it, c8, pp, zb); }
            }
        }
        if (PHEN(6) && ph_lo <= 6 && 6 < ph_hi) { PH_HEADER(); if (6 > ph_lo) grid_barrier((unsigned*)(ws + WS_BAR), xb_st, (unsigned)G, tid);
        for (int rep_ = 0; rep_ < DBLN(6); ++rep_) {
            { S.init(T, 2048, G, bid); EpiMerge E{gb, merged}; pg8::gemm_phase(glds, pg8::Gemm{zb, W_bm, T, 2048, 2048, 2048, 2048}, S, E, tid); }

        } }
        if (PHEN(7) && ph_lo <= 7 && 7 < ph_hi) { PH_HEADER(); if (7 > ph_lo) grid_barrier((unsigned*)(ws + WS_BAR), xb_st, (unsigned)G, tid);
        for (int rep_ = 0; rep_ < DBLN(7); ++rep_) {
            S.init(T, 2048, G, bid); EpiOut E{(bf16_t*)(ws + WS_ORAW)}; pg8::gemm_phase(glds, pg8::Gemm{merged, W_out, T, 2048, 2048, 2048, 2048}, S, E, tid);

        } }
        if (PHEN(8) && ph_lo <= 8 && 8 < ph_hi) { PH_HEADER(); if (8 > ph_lo) grid_barrier((unsigned*)(ws + WS_BAR), xb_st, (unsigned)G, tid);
            const bf16_t* oraw = (const bf16_t*)(ws + WS_ORAW);
            f32x4 gpost[4][2];
#pragma unroll
            for (int j = 0; j < 4; ++j)
#pragma unroll
                for (int hh = 0; hh < 2; ++hh) gpost[j][hh] = *(const f32x4*)(p.g_post + (j * 64 + lane) * 8 + hh * 4);
            for (int row = gw; row < T; row += NGW) { float* orow = p.out + (size_t)row * DM; const float* xr = p.x + (size_t)row * DM; float v[4][8]; float s = 0.f;
                u32x4 ow[4]; f32x4 xx[4][2];
#pragma unroll
                for (int j = 0; j < 4; ++j) { ow[j] = *(const u32x4*)(oraw + (size_t)row * DM + (j * 64 + lane) * 8);
#pragma unroll
                    for (int hh = 0; hh < 2; ++hh) xx[j][hh] = *(const f32x4*)(xr + (j * 64 + lane) * 8 + hh * 4); }
#pragma unroll
                for (int j = 0; j < 4; ++j) { unpack8(ow[j], v[j]);
#pragma unroll
                    for (int e = 0; e < 8; ++e) s += v[j][e] * v[j][e]; }
                const float rs = rsqrtf(wave_sum_fast(s) * (1.f / DM) + 1e-6f);
#pragma unroll
                for (int j = 0; j < 4; ++j) { const int c = (j * 64 + lane) * 8;
#pragma unroll
                    for (int hh = 0; hh < 2; ++hh) { const f32x4 gg = gpost[j][hh], xv = xx[j][hh];
                        *(f32x4*)(orow + c + hh * 4) = (f32x4){xv[0] + v[j][hh * 4 + 0] * rs * gg[0], xv[1] + v[j][hh * 4 + 1] * rs * gg[1], xv[2] + v[j][hh * 4 + 2] * rs * gg[2], xv[3] + v[j][hh * 4 + 3] * rs * gg[3]}; } } }
        }
}

constexpr int LDS_BYTES = LDS_PHASE_BYTES + 16;
constexpr int NPH = 9;
extern "C" void kernel_launch(void* const* d_in, const int* in_sizes, int n_in, void* d_out, int out_size, void* d_ws, size_t ws_size, hipStream_t stream) {
    static int grid = 0;
    if (grid == 0) {
        if (n_in != 25 || out_size != T * DM || ws_size < WS_END) { fprintf(stderr, "kernel_launch: shape mismatch n_in %d out %d ws %zu (need %zu)\n", n_in, out_size, ws_size, (size_t)WS_END); grid = -1; return; }
        int dev = 0, cus = 0, per_cu = 0;
        if (hipGetDevice(&dev) != hipSuccess || hipDeviceGetAttribute(&cus, hipDeviceAttributeMultiprocessorCount, dev) != hipSuccess) { grid = -1; return; }
        if (hipFuncSetAttribute((const void*)hybrid_fwd, hipFuncAttributeMaxDynamicSharedMemorySize, LDS_BYTES) != hipSuccess) { fprintf(stderr, "kernel_launch: hipFuncSetAttribute failed\n"); grid = -1; return; }
        if (hipOccupancyMaxActiveBlocksPerMultiprocessor(&per_cu, (const void*)hybrid_fwd, 512, LDS_BYTES) != hipSuccess || per_cu < 1) { fprintf(stderr, "kernel_launch: occupancy query says %d\n", per_cu); grid = -1; return; }
        grid = cus;
    }
    if (grid < 0) return;
    Params p{};
    const float** pp = (const float**)&p;
    for (int i = 0; i < 25; ++i) pp[i] = (const float*)d_in[i];
    p.out = (float*)d_out; p.ws = (unsigned char*)d_ws;
    if (hipMemsetAsync((char*)d_ws + WS_BAR, 0, 16384, stream) != hipSuccess) { fprintf(stderr, "kernel_launch: memset failed\n"); return; }
#if N_LAUNCHES == 1
    p.ph_lo = 0; p.ph_hi = NPH;
    void* args[] = {&p};
    hipError_t e = hipLaunchCooperativeKernel((const void*)hybrid_fwd, dim3(grid), dim3(512), args, LDS_BYTES, stream);
    if (e != hipSuccess) fprintf(stderr, "cooperative launch failed: %s (grid %d)\n", hipGetErrorString(e), grid);
#else
    for (int ph = 0; ph < NPH; ++ph) { p.ph_lo = ph; p.ph_hi = ph + 1; hipLaunchKernelGGL(hybrid_fwd, dim3(grid), dim3(512), LDS_BYTES, stream, p); }
#endif
}
```

```cpp
#include <hip/hip_runtime.h>
#include <hip/hip_cooperative_groups.h>
#include <cstdio>
#include <cstdint>
namespace cg = cooperative_groups;

#ifndef PH_MASK
#define PH_MASK 0x1ff
#endif
#define PHEN(i) ((PH_MASK >> (i)) & 1)
#ifndef DBL_MASK
#define DBL_MASK 0
#endif
#define DBLN(i) (1 + ((DBL_MASK >> (i)) & 1))
#ifndef N_LAUNCHES
#define N_LAUNCHES 1
#endif

constexpr int T = 16384, SEQ = 2048, DM = 2048, DIN = 10688;
constexpr int NP1 = 10752;
constexpr size_t MiB = 1u << 20;
constexpr size_t WS_WQ = 0, WS_WKV = WS_WQ + 1536 * 512 * 2, WS_LW = WS_WKV + 2048 * 512 * 2, WS_LA = WS_LW + 2048 * 256 * 2, WS_WBM = WS_LA + 2048 * 256 * 2,
                 WS_WBR = WS_WBM + 2048 * 1024 * 2, WS_WOUT = WS_WBR + 2048 * 1024 * 2, WS_CS = WS_WOUT + 2048 * 2048 * 2, WS_SSQ = WS_CS + 2048 * 32 * 8,
                 WS_SMALL_END = WS_SSQ + (size_t)T * 16 * 4;
static_assert(WS_SMALL_END <= 23 * MiB, "small region");
constexpr size_t WS_RKV = 23 * MiB, WS_Z = 119 * MiB, WS_KROPE = 183 * MiB, WS_H = 185 * MiB  , WS_Q = WS_H, WS_AW = 233 * MiB, WS_AA = 241 * MiB,
                 WS_KV = 249 * MiB  , WS_WIN = 313 * MiB, WS_QA = 355 * MiB, WS_KVA = 371 * MiB, WS_MISC = 387 * MiB, WS_UA = 313 * MiB  ,
                 WS_YF = 185 * MiB, WS_YB = 249 * MiB, WS_TMP = 313 * MiB, WS_MERGED = 185 * MiB, WS_ORAW = 313 * MiB  , WS_BAR = 441 * MiB, WS_END = 441 * MiB + 16384;

typedef unsigned short bf16_t;
typedef short bf16x8 __attribute__((ext_vector_type(8)));
typedef short s16x4 __attribute__((ext_vector_type(4)));
typedef float f32x4 __attribute__((ext_vector_type(4)));
typedef float f32x16 __attribute__((ext_vector_type(16)));
typedef unsigned u32x4 __attribute__((ext_vector_type(4)));
typedef float f32x2 __attribute__((ext_vector_type(2)));

struct Params {
    const float *x, *g_pre, *w_in, *q_norm, *wq_b, *kv_norm, *wkv_b, *mu, *w0_f, *w2_f, *w0_b, *w2_b, *a0_f, *a2_f, *a0_b, *a2_b, *k_k, *k_a, *r_k, *gn_g, *gn_b, *w_br_mla, *w_br_rwkv, *w_out, *g_post;
    float* out; unsigned char* ws; int ph_lo, ph_hi;
};

__device__ __forceinline__ unsigned cvt_pk_bf16(float lo, float hi) { unsigned r; asm volatile("v_cvt_pk_bf16_f32 %0, %1, %2" : "=v"(r) : "v"(lo), "v"(hi)); return r; }
__device__ __forceinline__ float bf2f(bf16_t b) { return __uint_as_float(((unsigned)b) << 16); }
__device__ __forceinline__ bf16_t f2bf(float f) { return (bf16_t)(cvt_pk_bf16(f, 0.f) & 0xffffu); }
__device__ __forceinline__ float h2f(unsigned short h) { _Float16 v; __builtin_memcpy(&v, &h, 2); return (float)v; }
__device__ __forceinline__ unsigned pk_f16(float a, float b) { _Float16 x = (_Float16)a, y = (_Float16)b; unsigned short xs, ys; __builtin_memcpy(&xs, &x, 2); __builtin_memcpy(&ys, &y, 2); return (unsigned)xs | ((unsigned)ys << 16); }
__device__ __forceinline__ float sigmoidf_(float v) { return __builtin_amdgcn_rcpf(1.f + __expf(-v)); }
__device__ __forceinline__ float wave_sum(float v) {
#pragma unroll
    for (int o = 1; o < 64; o <<= 1) v += __shfl_xor(v, o);
    return v;
}
template <int CTRL> __device__ __forceinline__ float dppx(float v) { return __int_as_float(__builtin_amdgcn_update_dpp(0, __float_as_int(v), CTRL, 0xF, 0xF, true)); }
__device__ __forceinline__ float red8(float v) { v += dppx<0xB1>(v); v += dppx<0x4E>(v); v += dppx<0x141>(v); return v; }
__device__ __forceinline__ float red16(float v) { v = red8(v); v += dppx<0x140>(v); return v; }
__device__ __forceinline__ float wave_sum_fast(float v) { v = red16(v); const int iv = __float_as_int(v);
    return (__int_as_float(__builtin_amdgcn_readlane(iv, 0)) + __int_as_float(__builtin_amdgcn_readlane(iv, 16))) + (__int_as_float(__builtin_amdgcn_readlane(iv, 32)) + __int_as_float(__builtin_amdgcn_readlane(iv, 48))); }
typedef unsigned u32x2 __attribute__((ext_vector_type(2)));
__device__ __forceinline__ void unpack4(u32x2 w, float* v) { v[0] = __uint_as_float(w.x << 16); v[1] = __uint_as_float(w.x & 0xffff0000u); v[2] = __uint_as_float(w.y << 16); v[3] = __uint_as_float(w.y & 0xffff0000u); }
__device__ __forceinline__ void unpack4h(u32x2 w, float* v) { v[0] = h2f((unsigned short)(w.x & 0xffffu)); v[1] = h2f((unsigned short)(w.x >> 16)); v[2] = h2f((unsigned short)(w.y & 0xffffu)); v[3] = h2f((unsigned short)(w.y >> 16)); }
__device__ __forceinline__ u32x4 pack8(const float* v) { u32x4 w; w.x = cvt_pk_bf16(v[0], v[1]); w.y = cvt_pk_bf16(v[2], v[3]); w.z = cvt_pk_bf16(v[4], v[5]); w.w = cvt_pk_bf16(v[6], v[7]); return w; }
__device__ __forceinline__ void unpack8(u32x4 w, float* v) {
    v[0] = __uint_as_float(w.x << 16); v[1] = __uint_as_float(w.x & 0xffff0000u); v[2] = __uint_as_float(w.y << 16); v[3] = __uint_as_float(w.y & 0xffff0000u);
    v[4] = __uint_as_float(w.z << 16); v[5] = __uint_as_float(w.z & 0xffff0000u); v[6] = __uint_as_float(w.w << 16); v[7] = __uint_as_float(w.w & 0xffff0000u);
}

namespace pg8 {
#define PG8_LAS __attribute__((address_space(3)))
constexpr int BM = 256, BK = 64, HALF = 128, HTB = HALF * BK * 2, STAGE_BYTES = 8 * HTB, NXCD = 8, WGM = 8;
__host__ __device__ __forceinline__ int lds_byte(int r, int c) { const int st = (r >> 4) * 2 + (c >> 5), rr = r & 15, cc = c & 31, ob = rr * 64 + cc * 2; return st * 1024 + (ob ^ (((ob >> 9) & 1) << 5)); }
__host__ __device__ __forceinline__ void stage_rc(int b, int& R, int& C) { const int st = b / 1024, sb = b % 1024, swz = sb ^ (((sb >> 9) & 1) << 5); R = (st >> 1) * 16 + swz / 64; C = (st & 1) * 32 + (swz % 64) / 2; }
__host__ __device__ __forceinline__ int perm32(int rho) { const int n = rho >> 4, i = rho & 15; return 8 * (i >> 2) + 4 * n + (i & 3); }
struct Unit { int pm, pn; };
struct Gemm { const bf16_t* A; const bf16_t* Bt; int M, N, K, lda, ldb; };
struct StaticOrder {
    int nM, nN, nwg, G, c;
    __host__ __device__ void init(int M, int N, int G_, int c_) { nM = M / BM; nN = N / BM; nwg = nM * nN; G = G_; c = c_; }
    __host__ __device__ bool next(int i, Unit& u) const {
        const long L = (long)i * G + c; if (L >= nwg) return false;
        int wgid = (int)L; { const int q = nwg / NXCD, r = nwg % NXCD, xcd = wgid % NXCD, off = wgid / NXCD; wgid = (xcd < r ? xcd * (q + 1) : r * (q + 1) + (xcd - r) * q) + off; }
        const int nig = WGM * nN, gid = wgid / nig, fm = gid * WGM, gsz = (nM - fm) < WGM ? (nM - fm) : WGM;
        u.pm = fm + ((wgid % nig) % gsz); u.pn = (wgid % nig) / gsz; return true;
    }
    __device__ __forceinline__ void a_ready(const Unit&) const {}
    __device__ __forceinline__ void done(const Unit&) const {}
};
template <class Epi, class Sched>
__device__ __forceinline__ void gemm_phase(PG8_LAS unsigned char* lds, const Gemm g, const Sched& S, const Epi& E, int tid_in) {
    int tid_l = tid_in; asm volatile("" : "+v"(tid_l));
    const int tid = tid_l, wid = __builtin_amdgcn_readfirstlane(tid >> 6), lane = tid & 63, wr = wid >> 2, wc = wid & 3, fr = lane & 15, fq = lane >> 4;
    const int K = g.K, nt = K / BK;
    unsigned voffA[2], voffB[2];
#pragma unroll
    for (int i = 0; i < 2; ++i) { int R, C; stage_rc(tid * 16 + i * 8192, R, C); const int Rb = Epi::PERM ? ((R & ~31) + perm32(R & 31)) : R;
        voffA[i] = (unsigned)(R * g.lda + C) * 2u; voffB[i] = (unsigned)(Rb * g.ldb + C) * 2u; }
    const size_t kstep = (size_t)(BK * 2);
    const size_t hstepA = (size_t)HALF * g.lda * 2, hstepB = (size_t)HALF * g.ldb * 2;
    const size_t tstepA = 2 * hstepA, tstepB = 2 * hstepB;
    const unsigned ldsw = (unsigned)wid * 1024u;
    const int aoff = lds_byte(wr * 64 + fr, fq * 8), boff = lds_byte(wc * 32 + fr, fq * 8);
#define PG8_SA(b, h) (((b) * 2 + (h)) * HTB)
#define PG8_SB(b, h) ((4 + (b) * 2 + (h)) * HTB)
#define PG8_STAGE(bufoff, gbase, voff) do { _Pragma("unroll") for (int _i = 0; _i < 2; ++_i) \
        __builtin_amdgcn_global_load_lds((const unsigned*)((const char*)(gbase) + (voff)[_i]), (PG8_LAS unsigned*)(lds + (bufoff) + ldsw + _i * 8192), 16, 0, 0); } while (0)
#define PG8_LDA(dst, b, h) do { _Pragma("unroll") for (int m = 0; m < 4; ++m) _Pragma("unroll") for (int k = 0; k < 2; ++k) dst[m][k] = *(const PG8_LAS bf16x8*)(lds + PG8_SA(b, h) + aoff + m * 2048 + k * 1024); } while (0)
#define PG8_LDB(dst, b, h) do { _Pragma("unroll") for (int n = 0; n < 2; ++n) _Pragma("unroll") for (int k = 0; k < 2; ++k) dst[n][k] = *(const PG8_LAS bf16x8*)(lds + PG8_SB(b, h) + boff + n * 2048 + k * 1024); } while (0)
#define PG8_MMA(ai, bj, At, Bt) do { __builtin_amdgcn_s_setprio(1); _Pragma("unroll") for (int m = 0; m < 4; ++m) _Pragma("unroll") for (int n = 0; n < 2; ++n) _Pragma("unroll") for (int k = 0; k < 2; ++k) \
        acc[ai][bj][m][n] = __builtin_amdgcn_mfma_f32_16x16x32_bf16(Bt[n][k], At[m][k], acc[ai][bj][m][n], 0, 0, 0); __builtin_amdgcn_s_setprio(0); } while (0)
#define PG8_WAIT_V(n) asm volatile("s_waitcnt vmcnt(" #n ")" ::: "memory")
#define PG8_WAIT_L(n) asm volatile("s_waitcnt lgkmcnt(" #n ")" ::: "memory")
#define PG8_BAR __builtin_amdgcn_s_barrier()
#define PG8_SCHED __builtin_amdgcn_sched_barrier(0)
    Unit cur, nxt; int ui = 0;
    if (!S.next(0, cur)) return;
    f32x4 acc[2][2][4][2];
#pragma unroll
    for (int a = 0; a < 2; ++a)
#pragma unroll
        for (int b = 0; b < 2; ++b)
#pragma unroll
            for (int m = 0; m < 4; ++m)
#pragma unroll
                for (int n = 0; n < 2; ++n) acc[a][b][m][n] = (f32x4){0.f, 0.f, 0.f, 0.f};
    bf16x8 At[4][2], B0[2][2], B1[2][2];
    const char* cA = (const char*)g.A + (size_t)cur.pm * tstepA; const char* cB = (const char*)g.Bt + (size_t)cur.pn * tstepB;
    S.a_ready(cur);
    PG8_STAGE(PG8_SB(0, 0), cB, voffB); PG8_STAGE(PG8_SA(0, 0), cA, voffA); PG8_STAGE(PG8_SB(0, 1), cB + hstepB, voffB); PG8_STAGE(PG8_SA(0, 1), cA + hstepA, voffA);
    if (wr == 1) PG8_BAR;
    PG8_WAIT_V(4); PG8_BAR;
    PG8_STAGE(PG8_SB(1, 0), cB + kstep, voffB); PG8_STAGE(PG8_SA(1, 0), cA + kstep, voffA); PG8_STAGE(PG8_SB(1, 1), cB + hstepB + kstep, voffB);
    PG8_WAIT_V(6); PG8_BAR;
    for (;;) {
        const bool has_next = S.next(ui + 1, nxt);
        const char* nA = has_next ? (const char*)g.A + (size_t)nxt.pm * tstepA : cA; const char* nB = has_next ? (const char*)g.Bt + (size_t)nxt.pn * tstepB : cB;
        for (int t = 0; t < nt; t += 2) {
            const bool last = (t == nt - 2);
            const char* a1 = cA + (size_t)(t + 1) * kstep;
            const char* a2 = last ? nA : cA + (size_t)(t + 2) * kstep; const char* b2 = last ? nB : cB + (size_t)(t + 2) * kstep;
            const char* a3 = a2 + kstep; const char* b3 = b2 + kstep;
            if (last && has_next) S.a_ready(nxt);
            if constexpr (Epi::MID) { if (t == (nt >> 1)) E.mid(acc, cur, wr, wc, fr, fq); }
            PG8_LDB(B0, 0, 0); PG8_SCHED; PG8_LDA(At, 0, 0); PG8_STAGE(PG8_SA(1, 1), a1 + hstepA, voffA);
            PG8_WAIT_L(8); PG8_BAR; PG8_WAIT_L(0); PG8_MMA(0, 0, At, B0); PG8_BAR; PG8_SCHED;
            PG8_LDB(B1, 0, 1); PG8_STAGE(PG8_SB(0, 0), b2, voffB);
            PG8_BAR; PG8_WAIT_L(0); PG8_MMA(0, 1, At, B1); PG8_BAR;
            PG8_LDA(At, 0, 1); PG8_STAGE(PG8_SA(0, 0), a2, voffA);
            PG8_BAR; PG8_WAIT_L(0); PG8_MMA(1, 0, At, B0); PG8_BAR; PG8_SCHED;
            PG8_STAGE(PG8_SB(0, 1), b2 + hstepB, voffB);
            PG8_WAIT_V(6); PG8_BAR; PG8_MMA(1, 1, At, B1); PG8_BAR;
            PG8_LDB(B0, 1, 0); PG8_SCHED; PG8_LDA(At, 1, 0); PG8_STAGE(PG8_SA(0, 1), a2 + hstepA, voffA);
            PG8_WAIT_L(8); PG8_BAR; PG8_WAIT_L(0); PG8_MMA(0, 0, At, B0); PG8_BAR; PG8_SCHED;
            PG8_LDB(B1, 1, 1); PG8_STAGE(PG8_SB(1, 0), b3, voffB);
            PG8_BAR; PG8_WAIT_L(0); PG8_MMA(0, 1, At, B1); PG8_BAR;
            PG8_LDA(At, 1, 1); PG8_STAGE(PG8_SA(1, 0), a3, voffA);
            PG8_BAR; PG8_WAIT_L(0); PG8_MMA(1, 0, At, B0); PG8_BAR; PG8_SCHED;
            PG8_STAGE(PG8_SB(1, 1), b3 + hstepB, voffB);
            PG8_WAIT_V(6); PG8_BAR; PG8_MMA(1, 1, At, B1); PG8_BAR;
        }
        E(acc, cur, wr, wc, fr, fq); S.done(cur);
        if (!has_next) break;
#pragma unroll
        for (int a = 0; a < 2; ++a)
#pragma unroll
            for (int b = 0; b < 2; ++b)
#pragma unroll
                for (int m = 0; m < 4; ++m)
#pragma unroll
                    for (int n = 0; n < 2; ++n) acc[a][b][m][n] = (f32x4){0.f, 0.f, 0.f, 0.f};
        cur = nxt; cA = nA; cB = nB; ++ui;
    }
    PG8_WAIT_V(0);
    if (wr == 0) PG8_BAR;
    PG8_BAR;
#undef PG8_SA
#undef PG8_SB
#undef PG8_STAGE
#undef PG8_LDA
#undef PG8_LDB
#undef PG8_MMA
#undef PG8_WAIT_V
#undef PG8_WAIT_L
#undef PG8_BAR
#undef PG8_SCHED
}
}
using pg8::Unit;
typedef const f32x4 (&AccRef)[2][2][4][2];

#define EPI_LOOP_ROWS _Pragma("unroll") for (int ai = 0; ai < 2; ++ai) _Pragma("unroll") for (int m = 0; m < 4; ++m)
#define EPI_GET8(v) float v[8]; { const f32x4 x0 = acc[ai][bj][m][0], x1 = acc[ai][bj][m][1]; v[0] = x0[0]; v[1] = x0[1]; v[2] = x0[2]; v[3] = x0[3]; v[4] = x1[0]; v[5] = x1[1]; v[6] = x1[2]; v[7] = x1[3]; }

__device__ __forceinline__ void rope8(float* v, const float* cs, int pos, int p0) {
    const f32x4 c0 = *(const f32x4*)(cs + ((size_t)pos * 32 + p0) * 2), c1 = *(const f32x4*)(cs + ((size_t)pos * 32 + p0 + 2) * 2);
    const float co[4] = {c0[0], c0[2], c1[0], c1[2]}, si[4] = {c0[1], c0[3], c1[1], c1[3]};
#pragma unroll
    for (int q = 0; q < 4; ++q) { const float a = v[2 * q], b = v[2 * q + 1]; v[2 * q] = a * co[q] - b * si[q]; v[2 * q + 1] = a * si[q] + b * co[q]; }
}

struct Epi1 {
    static constexpr bool PERM = true, MID = false;
    bf16_t *qa, *kva, *misc, *krope, *rkv, *z, *g; float* ssq; const float* cs;
    __device__ __forceinline__ void operator()(AccRef acc, const Unit& u, int wr, int wc, int fr, int fq) const {
        const int pn = u.pn, row0 = u.pm * 256 + wr * 64 + fr, cl = wc * 32 + 8 * fq;
        if (pn < 4) {
            bf16_t* dst = pn < 2 ? qa : kva; const int cbase = (pn & 1) * 256 + cl; float* sq = ssq + (pn < 2 ? 0 : 8) + (pn & 1) * 4 + wc;
            EPI_LOOP_ROWS { __builtin_amdgcn_sched_barrier(0); const int row = row0 + ai * 128 + m * 16; float ss = 0.f;
#pragma unroll
                for (int bj = 0; bj < 2; ++bj) { EPI_GET8(v);
#pragma unroll
                    for (int j = 0; j < 8; ++j) ss += v[j] * v[j];
                    __builtin_nontemporal_store(pack8(v), (u32x4*)(dst + (size_t)row * 512 + cbase + bj * 128)); }
                ss += __shfl_xor(ss, 16); ss += __shfl_xor(ss, 32);
                if (fq == 0) sq[(size_t)row * 16] = ss; }
        } else if (pn == 4) {
            EPI_LOOP_ROWS { __builtin_amdgcn_sched_barrier(0); const int row = row0 + ai * 128 + m * 16;
#pragma unroll
                for (int bj = 0; bj < 2; ++bj) { EPI_GET8(v); const int mc = bj * 128 + cl;
                    if (mc < 64) { rope8(v, cs, row & (SEQ - 1), mc >> 1); __builtin_nontemporal_store(pack8(v), (u32x4*)(krope + (size_t)row * 64 + mc)); }
                    else __builtin_nontemporal_store(pack8(v), (u32x4*)(misc + (size_t)row * 512 + mc)); } }
        } else {
            bf16_t* dst; int ld, act;
            if (pn == 5) { dst = misc + 256; ld = 512; act = 0; }
            else if (pn < 18) { dst = rkv + (pn - 6) * 256; ld = 3072; act = 0; }
            else if (pn < 26) { dst = z + (pn - 18) * 256; ld = 2048; act = 1; }
            else { dst = g + (pn - 26) * 256; ld = 4096; act = 2; }
            dst += cl;
            EPI_LOOP_ROWS { __builtin_amdgcn_sched_barrier(0); const int row = row0 + ai * 128 + m * 16;
#pragma unroll
                for (int bj = 0; bj < 2; ++bj) { EPI_GET8(v);
                    if (act) {
#pragma unroll
                        for (int j = 0; j < 8; ++j) { const float sg = sigmoidf_(v[j]); v[j] = act == 1 ? v[j] * sg : sg; } }
                    __builtin_nontemporal_store(pack8(v), (u32x4*)(dst + (size_t)row * ld + bj * 128)); } }
        }
    }
};
__device__ __forceinline__ float rstd_from_ssq(const float* sq) { const f32x4 a = *(const f32x4*)sq, b = *(const f32x4*)(sq + 4); const float s = ((a[0] + a[1]) + (a[2] + a[3])) + ((b[0] + b[1]) + (b[2] + b[3])); return rsqrtf(s * (1.f / 512.f) + 1e-6f); }
struct EpiQ {
    static constexpr bool PERM = true, MID = false;
    bf16_t* q; const float* ssq; const float* cs;
    __device__ __forceinline__ void operator()(AccRef acc, const Unit& u, int wr, int wc, int fr, int fq) const {
        const int row0 = u.pm * 256 + wr * 64 + fr, cl = u.pn * 256 + wc * 32 + 8 * fq;
        float rsv[2][4];
        EPI_LOOP_ROWS rsv[ai][m] = rstd_from_ssq(ssq + (size_t)(row0 + ai * 128 + m * 16) * 16);
        EPI_LOOP_ROWS { __builtin_amdgcn_sched_barrier(0); const int row = row0 + ai * 128 + m * 16; const float rs = rsv[ai][m];
#pragma unroll
            for (int bj = 0; bj < 2; ++bj) { EPI_GET8(v); const int gc = cl + bj * 128, hc = gc % 192;
#pragma unroll
                for (int j = 0; j < 8; ++j) v[j] *= rs;
                if (hc >= 128) rope8(v, cs, row & (SEQ - 1), (hc - 128) >> 1);
                *(u32x4*)(q + (size_t)row * 1536 + gc) = pack8(v); } }
    }
};
struct EpiKV {
    static constexpr bool PERM = true, MID = false;
    bf16_t* kv; const float* ssq;
    __device__ __forceinline__ void operator()(AccRef acc, const Unit& u, int wr, int wc, int fr, int fq) const {
        const int row0 = u.pm * 256 + wr * 64 + fr, cl = u.pn * 256 + wc * 32 + 8 * fq;
        float rsv[2][4];
        EPI_LOOP_ROWS rsv[ai][m] = rstd_from_ssq(ssq + (size_t)(row0 + ai * 128 + m * 16) * 16 + 8);
        EPI_LOOP_ROWS { __builtin_amdgcn_sched_barrier(0); const int row = row0 + ai * 128 + m * 16; const float rs = rsv[ai][m];
#pragma unroll
            for (int bj = 0; bj < 2; ++bj) { EPI_GET8(v);
#pragma unroll
                for (int j = 0; j < 8; ++j) v[j] *= rs;
                *(u32x4*)(kv + (size_t)row * 2048 + cl + bj * 128) = pack8(v); } }
    }
};
struct EpiLora {
    static constexpr bool PERM = true, MID = false;
    unsigned short* ua; int off; const float *bias_f, *bias_b;
    __device__ __forceinline__ void operator()(AccRef acc, const Unit& u, int wr, int wc, int fr, int fq) const {
        const int row0 = u.pm * 256 + wr * 64 + fr, cl = u.pn * 256 + wc * 32 + 8 * fq; const float* bias = u.pn < 4 ? bias_f : bias_b - 1024;
#pragma unroll
        for (int bj = 0; bj < 2; ++bj) { const int gc = cl + bj * 128; const f32x4 b0 = *(const f32x4*)(bias + gc), b1 = *(const f32x4*)(bias + gc + 4);
            EPI_LOOP_ROWS { __builtin_amdgcn_sched_barrier(0); const int row = row0 + ai * 128 + m * 16; EPI_GET8(v);
                u32x4 w; w.x = pk_f16(sigmoidf_(v[0] + b0[0]), sigmoidf_(v[1] + b0[1])); w.y = pk_f16(sigmoidf_(v[2] + b0[2]), sigmoidf_(v[3] + b0[3]));
                w.z = pk_f16(sigmoidf_(v[4] + b1[0]), sigmoidf_(v[5] + b1[1])); w.w = pk_f16(sigmoidf_(v[6] + b1[2]), sigmoidf_(v[7] + b1[3]));
                *(u32x4*)(ua + (size_t)row * 4096 + off + gc) = w; } }
    }
};
struct EpiMerge {
    static constexpr bool PERM = true, MID = true;
    const bf16_t* g; bf16_t* merged;
    __device__ __forceinline__ void mid(f32x4 (&acc)[2][2][4][2], const Unit& u, int wr, int wc, int fr, int fq) const {
        int row0 = u.pm * 256 + wr * 64 + fr, cl = u.pn * 256 + wc * 32 + 8 * fq; asm volatile("" : "+v"(row0), "+v"(cl));
#pragma unroll
        for (int ai = 0; ai < 2; ++ai) { u32x4 w1[4][2], w2[4][2];
            __builtin_amdgcn_sched_barrier(0);
#pragma unroll
            for (int m = 0; m < 4; ++m)
#pragma unroll
                for (int bj = 0; bj < 2; ++bj) { const bf16_t* gp = g + (size_t)(row0 + ai * 128 + m * 16) * 4096 + cl + bj * 128; w1[m][bj] = *(const u32x4*)gp; w2[m][bj] = *(const u32x4*)(gp + 2048); }
            __builtin_amdgcn_sched_barrier(0);
#pragma unroll
            for (int m = 0; m < 4; ++m)
#pragma unroll
                for (int bj = 0; bj < 2; ++bj) { float g1[8], g2[8]; unpack8(w1[m][bj], g1); unpack8(w2[m][bj], g2);
#pragma unroll
                    for (int j = 0; j < 4; ++j) { acc[ai][bj][m][0][j] *= g1[j] * __builtin_amdgcn_rcpf(fmaxf(g2[j], 1e-30f)); acc[ai][bj][m][1][j] *= g1[4 + j] * __builtin_amdgcn_rcpf(fmaxf(g2[4 + j], 1e-30f)); } } }
    }
    __device__ __forceinline__ void operator()(AccRef acc, const Unit& u, int wr, int wc, int fr, int fq) const {
        const int row0 = u.pm * 256 + wr * 64 + fr, cl = u.pn * 256 + wc * 32 + 8 * fq;
#pragma unroll
        for (int ai = 0; ai < 2; ++ai) { u32x4 w2[4][2];
            __builtin_amdgcn_sched_barrier(0);
#pragma unroll
            for (int m = 0; m < 4; ++m)
#pragma unroll
                for (int bj = 0; bj < 2; ++bj) w2[m][bj] = *(const u32x4*)(g + (size_t)(row0 + ai * 128 + m * 16) * 4096 + 2048 + cl + bj * 128);
            __builtin_amdgcn_sched_barrier(0);
#pragma unroll
            for (int m = 0; m < 4; ++m) { const int row = row0 + ai * 128 + m * 16;
#pragma unroll
                for (int bj = 0; bj < 2; ++bj) { EPI_GET8(v); const int gc = cl + bj * 128; float g2[8]; unpack8(w2[m][bj], g2);
#pragma unroll
                    for (int j = 0; j < 8; ++j) v[j] *= g2[j];
                    *(u32x4*)(merged + (size_t)row * 2048 + gc) = pack8(v); } } }
    }
};
struct EpiOut {
    static constexpr bool PERM = true, MID = false;
    bf16_t* o;
    __device__ __forceinline__ void operator()(AccRef acc, const Unit& u, int wr, int wc, int fr, int fq) const {
        const int row0 = u.pm * 256 + wr * 64 + fr, cl = u.pn * 256 + wc * 32 + 8 * fq;
        EPI_LOOP_ROWS { __builtin_amdgcn_sched_barrier(0); const int row = row0 + ai * 128 + m * 16;
#pragma unroll
            for (int bj = 0; bj < 2; ++bj) { EPI_GET8(v); *(u32x4*)(o + (size_t)row * 2048 + cl + bj * 128) = pack8(v); } }
    }
};

namespace att {
constexpr int NW = 8, QBLK = 32, KVBLK = 64;
constexpr float SCALE = 0.07216878364870322f;
constexpr float THR = 8.f;
constexpr int LDQ = 1536, LDK = 2048, LDR = 64, LDO = 2048;
constexpr size_t SHM_V = KVBLK * 128 * 2, SHM_K = KVBLK * 128 * 2, SHM_R = KVBLK * 64 * 2;
#define KSWZ(row, colB) ((row) * 256 + ((colB) ^ (((row) & 7) << 4)))
#define RSWZ(row, colB) ((row) * 128 + ((colB) ^ ((((row) >> 1) & 7) << 4)))
#define SBAR() __builtin_amdgcn_sched_barrier(0)
__device__ __forceinline__ int crow(int r, int hi) { return (r & 3) + 8 * (r >> 2) + 4 * hi; }
__device__ __forceinline__ void partialSM(f32x16& p0, f32x16& p1, float& m_reg, float& mn, float& alpha) {
    constexpr float C = SCALE * 1.4426950408889634f;
    float pmax = p0[0];
#pragma unroll
    for (int r = 1; r < 16; ++r) pmax = fmaxf(pmax, p0[r]);
#pragma unroll
    for (int r = 0; r < 16; ++r) pmax = fmaxf(pmax, p1[r]);
    { auto rr = __builtin_amdgcn_permlane32_swap(__float_as_uint(pmax), __float_as_uint(pmax), false, false); pmax = fmaxf(__uint_as_float(rr[0]), __uint_as_float(rr[1])); }
    if (__builtin_expect(__all(pmax - m_reg <= THR / SCALE), 1)) { mn = m_reg; alpha = 1.f; }
    else { mn = fmaxf(m_reg, pmax); alpha = __builtin_amdgcn_exp2f((m_reg - mn) * C); m_reg = mn; }
    const float mnC = -mn * C;
#pragma unroll
    for (int r = 0; r < 16; ++r) p0[r] = fmaf(p0[r], C, mnC);
#pragma unroll
    for (int r = 0; r < 16; ++r) p1[r] = fmaf(p1[r], C, mnC);
#pragma unroll
    for (int r = 0; r < 16; ++r) p0[r] = __builtin_amdgcn_exp2f(p0[r]);
}
__device__ __forceinline__ void finishSM(f32x16& p0, f32x16& p1, float alpha, float& l_reg, bf16x8& pa0, bf16x8& pa1, bf16x8& pa2, bf16x8& pa3) {
#pragma unroll
    for (int r = 0; r < 16; ++r) p1[r] = __builtin_amdgcn_exp2f(p1[r]);
    float ps = 0;
#pragma unroll
    for (int r = 0; r < 16; ++r) ps += p0[r];
#pragma unroll
    for (int r = 0; r < 16; ++r) ps += p1[r];
    { auto rr = __builtin_amdgcn_permlane32_swap(__float_as_uint(ps), __float_as_uint(ps), false, false); ps = __uint_as_float(rr[0]) + __uint_as_float(rr[1]); }
    l_reg = l_reg * alpha + ps;
#define PK4(P, BASE, OUT) do { unsigned a0 = cvt_pk_bf16(P[BASE + 0], P[BASE + 1]), a1 = cvt_pk_bf16(P[BASE + 2], P[BASE + 3]);   \
    unsigned b0 = cvt_pk_bf16(P[BASE + 4], P[BASE + 5]), b1 = cvt_pk_bf16(P[BASE + 6], P[BASE + 7]);                              \
    auto r0 = __builtin_amdgcn_permlane32_swap(a0, b0, false, false); auto r1 = __builtin_amdgcn_permlane32_swap(a1, b1, false, false); \
    u32x4 w = {r0[0], r1[0], r0[1], r1[1]}; OUT = *reinterpret_cast<bf16x8*>(&w); } while (0)
    PK4(p0, 0, pa0); PK4(p0, 8, pa1); PK4(p1, 0, pa2); PK4(p1, 8, pa3);
#undef PK4
}
__device__ __forceinline__ void qkt(f32x16& p0, f32x16& p1, const char* Ks, const char* Rs, const bf16x8* qr, const char* qrl, int r32, int hi) {
    p0 = f32x16{}; p1 = f32x16{};
#pragma unroll
    for (int d0 = 0; d0 < 8; ++d0) { const int cb = (d0 * 16 + hi * 8) * 2;
        const bf16x8 b0 = *reinterpret_cast<const bf16x8*>(Ks + KSWZ(r32, cb));
        const bf16x8 b1 = *reinterpret_cast<const bf16x8*>(Ks + KSWZ(32 + r32, cb));
        const bf16x8 qv = d0 < 6 ? qr[d0] : *reinterpret_cast<const bf16x8*>(qrl + (d0 - 6) * 1024);
        p0 = __builtin_amdgcn_mfma_f32_32x32x16_bf16(b0, qv, p0, 0, 0, 0);
        p1 = __builtin_amdgcn_mfma_f32_32x32x16_bf16(b1, qv, p1, 0, 0, 0); }
#pragma unroll
    for (int d0 = 0; d0 < 4; ++d0) { const int cb = (d0 * 16 + hi * 8) * 2;
        const bf16x8 b0 = *reinterpret_cast<const bf16x8*>(Rs + RSWZ(r32, cb));
        const bf16x8 b1 = *reinterpret_cast<const bf16x8*>(Rs + RSWZ(32 + r32, cb));
        const bf16x8 qv = *reinterpret_cast<const bf16x8*>(qrl + (2 + d0) * 1024);
        p0 = __builtin_amdgcn_mfma_f32_32x32x16_bf16(b0, qv, p0, 0, 0, 0);
        p1 = __builtin_amdgcn_mfma_f32_32x32x16_bf16(b1, qv, p1, 0, 0, 0); }
}
__device__ __forceinline__ int v_st(int k, int c) { const int kk = (k & ~0xC) | ((k & 4) << 1) | ((k & 8) >> 1); return ((kk >> 3) * 4 + (c >> 5)) * 512 + ((kk & 7) * 32 + (c & 31)) * 2; }
__device__ __forceinline__ int v_rd_base(int lane) { return ((lane & 3) << 3) | (((lane >> 2) & 3) << 6) | (((lane >> 4) & 1) << 5) | (((lane >> 5) & 1) << 8); }
constexpr int v_rd_off(int d0, int ks, int half) { return d0 * 512 + ks * 4096 + half * 2048; }
template <int OFF> __device__ __forceinline__ s16x4 tr_read(int vb) { s16x4 r; asm volatile("ds_read_b64_tr_b16 %0, %1 offset:%2" : "=&v"(r) : "v"(vb), "i"(OFF) : "memory"); return r; }
template <int D0> __device__ __forceinline__ void pv_one(f32x16& od, int vb, bf16x8 pa0, bf16x8 pa1, bf16x8 pa2, bf16x8 pa3) {
    const s16x4 l0 = tr_read<v_rd_off(D0, 0, 0)>(vb), h0 = tr_read<v_rd_off(D0, 0, 1)>(vb), l1 = tr_read<v_rd_off(D0, 1, 0)>(vb), h1 = tr_read<v_rd_off(D0, 1, 1)>(vb);
    const s16x4 l2 = tr_read<v_rd_off(D0, 2, 0)>(vb), h2 = tr_read<v_rd_off(D0, 2, 1)>(vb), l3 = tr_read<v_rd_off(D0, 3, 0)>(vb), h3 = tr_read<v_rd_off(D0, 3, 1)>(vb);
    asm volatile("s_waitcnt lgkmcnt(0)" ::: "memory"); SBAR();
#define PK(L, H) (bf16x8){L[0], L[1], L[2], L[3], H[0], H[1], H[2], H[3]}
    od = __builtin_amdgcn_mfma_f32_32x32x16_bf16(pa0, PK(l0, h0), od, 0, 0, 0);
    od = __builtin_amdgcn_mfma_f32_32x32x16_bf16(pa1, PK(l1, h1), od, 0, 0, 0);
    od = __builtin_amdgcn_mfma_f32_32x32x16_bf16(pa2, PK(l2, h2), od, 0, 0, 0);
    od = __builtin_amdgcn_mfma_f32_32x32x16_bf16(pa3, PK(l3, h3), od, 0, 0, 0);
#undef PK
}
__device__ __forceinline__ void pv_d0(f32x16* o, int vb, bf16x8 pa0, bf16x8 pa1, bf16x8 pa2, bf16x8 pa3) {
    pv_one<0>(o[0], vb, pa0, pa1, pa2, pa3); pv_one<1>(o[1], vb, pa0, pa1, pa2, pa3); pv_one<2>(o[2], vb, pa0, pa1, pa2, pa3); pv_one<3>(o[3], vb, pa0, pa1, pa2, pa3);
}
__device__ __forceinline__ void attn_body(const bf16_t* __restrict__ Qb, const bf16_t* __restrict__ Kh, const bf16_t* __restrict__ Vh, const bf16_t* __restrict__ Rh,
                                          bf16_t* __restrict__ Zb, int seq, char* lds, int tid_in) {
    int tid_l = tid_in; asm volatile("" : "+v"(tid_l));
    const int tid = tid_l, wid = tid >> 6, lane = tid & 63, r32 = lane & 31, hi = lane >> 5;
    char* V_lds = lds; char* K_lds = lds + 2 * SHM_V; char* R_lds = lds + 2 * SHM_V + 2 * SHM_K;
    float* wsf = (float*)(lds + 2 * SHM_V + 2 * SHM_K + 2 * SHM_R) + wid * 64; float* li_l = wsf; float* al_l = wsf + 32;
    float m_reg = -1e30f, l_reg = 0; f32x16 o[4] = {}; bf16x8 qr[6];
    char* qrl = lds + 2 * SHM_V + 2 * SHM_K + 2 * SHM_R + 2048 + wid * 6144 + lane * 16;
    const bf16_t* Qw = Qb + (long)(wid * QBLK + r32) * LDQ + hi * 8;
#pragma unroll
    for (int d0 = 0; d0 < 6; ++d0) qr[d0] = *reinterpret_cast<const bf16x8*>(Qw + d0 * 16);
    const int sr = tid >> 4, sc = (tid & 15) * 8, vst0 = v_st(sr, sc), vst1 = v_st(32 + sr, sc);
    const int rr_ = tid >> 3, rc_ = (tid & 7) * 8;
    const int vb0 = (int)(uintptr_t)V_lds + v_rd_base(lane);
    struct { bf16x8 vs0, vs1, ks0, ks1, rs; } sr_[1];
#define SLOAD(i, k0) do { sr_[i].vs0 = *(const bf16x8*)(&Vh[(long)((k0) + sr) * LDK + sc]); sr_[i].vs1 = *(const bf16x8*)(&Vh[(long)((k0) + 32 + sr) * LDK + sc]); \
    sr_[i].ks0 = *(const bf16x8*)(&Kh[(long)((k0) + sr) * LDK + sc]); sr_[i].ks1 = *(const bf16x8*)(&Kh[(long)((k0) + 32 + sr) * LDK + sc]); \
    sr_[i].rs = *(const bf16x8*)(&Rh[(long)((k0) + rr_) * LDR + rc_]); } while (0)
#define SWRITE(b, i) do { *(bf16x8*)(V_lds + (b) * SHM_V + vst0) = sr_[i].vs0; *(bf16x8*)(V_lds + (b) * SHM_V + vst1) = sr_[i].vs1; const int kc = sc * 2;  \
    *(bf16x8*)(K_lds + (b) * SHM_K + KSWZ(sr, kc)) = sr_[i].ks0; *(bf16x8*)(K_lds + (b) * SHM_K + KSWZ(32 + sr, kc)) = sr_[i].ks1; \
    *(bf16x8*)(R_lds + (b) * SHM_R + RSWZ(rr_, rc_ * 2)) = sr_[i].rs; } while (0)
#define SWAIT() asm volatile("s_waitcnt vmcnt(0)" ::: "memory")
#define RESC(a) do { if (__any((a) < 1.f)) { if (hi == 0) al_l[r32] = (a); asm volatile("s_waitcnt lgkmcnt(0)" ::: "memory"); \
    _Pragma("unroll") for (int d = 0; d < 4; ++d) _Pragma("unroll") for (int r = 0; r < 16; ++r) o[d][r] *= al_l[crow(r, hi)]; } } while (0)
    f32x16 pA0, pA1, pB0, pB1; float mnA, mnB, alA, alB; bf16x8 pa0, pa1, pa2, pa3; const int NT = seq / KVBLK;
    __syncthreads();
#pragma unroll
    for (int d0 = 0; d0 < 6; ++d0) *reinterpret_cast<bf16x8*>(qrl + d0 * 1024) = *reinterpret_cast<const bf16x8*>(Qw + 96 + d0 * 16);
    SLOAD(0, 0); asm volatile("s_waitcnt vmcnt(0)" ::: "memory"); SWRITE(0, 0); __syncthreads();
    qkt(pA0, pA1, K_lds, R_lds, qr, qrl, r32, hi); partialSM(pA0, pA1, m_reg, mnA, alA);
    SLOAD(0, KVBLK);
    SWAIT(); SWRITE(1, 0); __syncthreads();
    for (int j = 1; j + 1 < NT; j += 2) {
        SBAR(); qkt(pB0, pB1, K_lds + SHM_K, R_lds + SHM_R, qr, qrl, r32, hi);
        finishSM(pA0, pA1, alA, l_reg, pa0, pa1, pa2, pa3); SBAR();
        SLOAD(0, (j + 1) * KVBLK); SBAR();
        pv_d0(o, vb0, pa0, pa1, pa2, pa3); partialSM(pB0, pB1, m_reg, mnB, alB);
        __syncthreads(); SWAIT(); SWRITE(0, 0);
        RESC(alB); __syncthreads();
        SBAR(); qkt(pA0, pA1, K_lds, R_lds, qr, qrl, r32, hi);
        finishSM(pB0, pB1, alB, l_reg, pa0, pa1, pa2, pa3); SBAR();
        SLOAD(0, (j + 2) * KVBLK); SBAR();
        pv_d0(o, vb0 + (int)SHM_V, pa0, pa1, pa2, pa3); partialSM(pA0, pA1, m_reg, mnA, alA);
        __syncthreads(); SWAIT(); SWRITE(1, 0);
        RESC(alA); __syncthreads();
    }
    SBAR(); qkt(pB0, pB1, K_lds + SHM_K, R_lds + SHM_R, qr, qrl, r32, hi);
    finishSM(pA0, pA1, alA, l_reg, pa0, pa1, pa2, pa3); SBAR();
    pv_d0(o, vb0, pa0, pa1, pa2, pa3); partialSM(pB0, pB1, m_reg, mnB, alB);
    __syncthreads(); RESC(alB);
    finishSM(pB0, pB1, alB, l_reg, pa0, pa1, pa2, pa3); SBAR();
    pv_d0(o, vb0 + (int)SHM_V, pa0, pa1, pa2, pa3);
    if (hi == 0) li_l[r32] = l_reg;
    __syncthreads();
    { constexpr int SP = 272;
      char* stg = lds + wid * (32 * SP);
#pragma unroll
      for (int r = 0; r < 16; ++r) { const int orow = crow(r, hi); const float rli = __builtin_amdgcn_rcpf(li_l[orow]);
#pragma unroll
          for (int d0 = 0; d0 < 4; ++d0) *(bf16_t*)(stg + orow * SP + (d0 * 32 + r32) * 2) = f2bf(o[d0][r] * rli); }
      asm volatile("s_waitcnt lgkmcnt(0)" ::: "memory");
      bf16_t* Zw = Zb + (long)(wid * QBLK) * LDO;
      u32x4 zw[8];
#pragma unroll
      for (int i = 0; i < 8; ++i) { const int c = i * 64 + lane; zw[i] = *(const u32x4*)(Zw + (long)(c >> 4) * LDO + (c & 15) * 8); }
#pragma unroll
      for (int i = 0; i < 8; ++i) { const int c = i * 64 + lane, row = c >> 4, col8 = (c & 15) * 8;
          float ov[8], zv[8]; unpack8(*(const u32x4*)(stg + row * SP + col8 * 2), ov); unpack8(zw[i], zv);
#pragma unroll
          for (int e = 0; e < 8; ++e) ov[e] *= zv[e];
          *(u32x4*)(Zw + (long)row * LDO + col8) = pack8(ov); } }
#undef SLOAD
#undef SWRITE
#undef SWAIT
#undef RESC
}
}

__device__ __forceinline__ int map_col(int mode, int n) {
    if (mode == 1) {
        if (n < 1024) return n;
        if (n < 1536) { const int m = n - 1024; if (m < 64) return 1024 + (m >> 1) + 32 * (m & 1); if (m < 448) return 4096 + m; return -1; }
        if (n < 4608) return 1088 + (n - 1536);
        return n - 64;
    }
    if (mode == 2) { const int h = n / 192, c = n % 192; if (c < 128) return n; const int m = c - 128; return h * 192 + 128 + (m >> 1) + 32 * (m & 1); }
    return n;
}
__device__ __forceinline__ void transpose_tile(const float* src, int lds_, int K, bf16_t* dst, int mode, const float* scale, int tile, float* tl, int tid, int ldd = 0) {
    if (ldd == 0) ldd = K;
    const int nkb = K / 64, nb = tile / nkb, kb = tile % nkb, n0 = nb * 64, k0 = kb * 64;
    const int s0 = map_col(mode, n0), s63 = map_col(mode, n0 + 63);
    __syncthreads();
    if ((s0 >= 0 && s63 == s0 + 63 && map_col(mode, n0 + 1) == s0 + 1) || (s0 < 0 && s63 < 0)) {
        const int n4 = (tid & 15) * 4;
#pragma unroll
        for (int it = 0; it < 2; ++it) { const int kk = (tid >> 4) + 32 * it; f32x4 v = s0 >= 0 ? *(const f32x4*)(src + (size_t)(k0 + kk) * lds_ + s0 + n4) : (f32x4){0.f, 0.f, 0.f, 0.f};
            if (scale) v = v * scale[k0 + kk];
            tl[kk * 65 + n4 + 0] = v[0]; tl[kk * 65 + n4 + 1] = v[1]; tl[kk * 65 + n4 + 2] = v[2]; tl[kk * 65 + n4 + 3] = v[3]; }
    } else {
        const int nn = tid & 63, sc = map_col(mode, n0 + nn);
#pragma unroll
        for (int it = 0; it < 8; ++it) { const int kk = (tid >> 6) + 8 * it; float v = sc >= 0 ? src[(size_t)(k0 + kk) * lds_ + sc] : 0.f; if (scale) v *= scale[k0 + kk]; tl[kk * 65 + nn] = v; }
    }
    __syncthreads();
    const int nr = tid >> 3, kc = (tid & 7) * 8; float v[8];
#pragma unroll
    for (int e = 0; e < 8; ++e) v[e] = tl[(kc + e) * 65 + nr];
    *(u32x4*)(dst + (size_t)(n0 + nr) * ldd + k0 + kc) = pack8(v);
}

constexpr int SC_C = 32;
struct ScanOps { f32x4 w0, w1, a0, a1, b0, b1, k0, k1, r0, r1; float v; };
__device__ __forceinline__ void scan_chain(const Params& p, int c, char* lds, int tid_in) {
    const bf16_t* rkv = (const bf16_t*)(p.ws + WS_RKV); const unsigned short* ua = (const unsigned short*)(p.ws + WS_UA);
    const int dir = c >> 7, b = (c >> 4) & 7, h = c & 15;
    float* yout = (float*)(p.ws + (dir ? WS_YB : WS_YF));
    int tid_l = tid_in; asm volatile("" : "+v"(tid_l));
    const int tid = tid_l, wid = tid >> 6, lane = tid & 63, row = tid >> 3, sub = tid & 7;
    float* L = (float*)lds;
    float* ybuf = L + 2 * 6 * SC_C * 64;
    const int psl = tid >> 4, pc4 = (tid & 15) * 4, ch = h * 64 + pc4;
    const f32x4 mu_r = *(const f32x4*)(p.mu + ch), mu_k = *(const f32x4*)(p.mu + 1024 + ch), mu_v = *(const f32x4*)(p.mu + 2048 + ch), kk_c = *(const f32x4*)(p.k_k + ch), ka_c = *(const f32x4*)(p.k_a + ch);
    f32x2 s01 = {0.f, 0.f}, s23 = {0.f, 0.f}, s45 = {0.f, 0.f}, s67 = {0.f, 0.f};
    u32x2 raw[3][3], raw_u, raw_a;
    const size_t tok0 = (size_t)b * SEQ;
#define SC_LOAD(chunk) do { const int st = (chunk) * SC_C + psl; const int t = dir ? (SEQ - 1 - st) : st; \
        const bf16_t* base = rkv + (tok0 + t) * 3072 + ch; const bool hm = t > 0, hp = t < SEQ - 1; \
        _Pragma("unroll") for (int sg = 0; sg < 3; ++sg) { raw[sg][1] = *(const u32x2*)(base + sg * 1024); \
            raw[sg][0] = hm ? *(const u32x2*)(base + sg * 1024 - 3072) : (u32x2){0u, 0u}; raw[sg][2] = hp ? *(const u32x2*)(base + sg * 1024 + 3072) : (u32x2){0u, 0u}; } \
        const unsigned short* ub = ua + (tok0 + t) * 4096 + dir * 1024 + ch; raw_u = *(const u32x2*)ub; raw_a = *(const u32x2*)(ub + 2048); } while (0)
#define SC_PREP(bufi) do { float* Lb = L + (bufi) * 6 * SC_C * 64 + psl * 64 + pc4; float rr[3][3][4]; \
        _Pragma("unroll") for (int sg = 0; sg < 3; ++sg) _Pragma("unroll") for (int d = 0; d < 3; ++d) unpack4(raw[sg][d], rr[sg][d]); \
        float uu[4], aa[4]; unpack4h(raw_u, uu); unpack4h(raw_a, aa); f32x4 r4, k4, v4, kk4; float n2 = 0.f; \
        _Pragma("unroll") for (int e = 0; e < 4; ++e) { r4[e] = rr[0][1][e] + mu_r[e] * (0.5f * (rr[0][0][e] + rr[0][2][e]) - rr[0][1][e]); k4[e] = rr[1][1][e] + mu_k[e] * (0.5f * (rr[1][0][e] + rr[1][2][e]) - rr[1][1][e]); \
            v4[e] = rr[2][1][e] + mu_v[e] * (0.5f * (rr[2][0][e] + rr[2][2][e]) - rr[2][1][e]); kk4[e] = k4[e] * kk_c[e]; n2 += kk4[e] * kk4[e]; } \
        const float rn = __builtin_amdgcn_rsqf(fmaxf(red16(n2), 1e-24f)); f32x4 w4, na4, b4, kf4; \
        _Pragma("unroll") for (int e = 0; e < 4; ++e) { const float kk = kk4[e] * rn; w4[e] = __expf(-0.6065306597126334f * uu[e]); na4[e] = -kk; b4[e] = kk * aa[e]; kf4[e] = k4[e] * (1.f + (aa[e] - 1.f) * ka_c[e]); } \
        *(f32x4*)(Lb + 0 * SC_C * 64) = w4; *(f32x4*)(Lb + 1 * SC_C * 64) = na4; *(f32x4*)(Lb + 2 * SC_C * 64) = b4; *(f32x4*)(Lb + 3 * SC_C * 64) = kf4; *(f32x4*)(Lb + 4 * SC_C * 64) = r4; *(f32x4*)(Lb + 5 * SC_C * 64) = v4; } while (0)
#define SC_FLUSH(chunk) do { const float* yb = ybuf + ((chunk) & 1) * SC_C * 64; const int sl = tid >> 4, i4 = (tid & 15) * 4; const int st = (chunk) * SC_C + sl; const int t = dir ? (SEQ - 1 - st) : st; \
        *(f32x4*)(yout + (tok0 + t) * 1024 + h * 64 + i4) = *(const f32x4*)(yb + sl * 64 + i4); } while (0)
    constexpr int NCH = SEQ / SC_C;
    __syncthreads();
    SC_LOAD(0); SC_PREP(0); __syncthreads();
    for (int n = 0; n < NCH; ++n) {
        if (n + 1 < NCH) SC_LOAD(n + 1);
        if (n > 0) SC_FLUSH(n - 1);
        const float* Lb = L + (n & 1) * 6 * SC_C * 64 + sub * 8; float* yb = ybuf + (n & 1) * SC_C * 64;
        const float* Lv = L + (n & 1) * 6 * SC_C * 64 + 5 * SC_C * 64 + row;
#define SC_LDA(O, sl) do { O.w0 = *(const f32x4*)(Lb + (0 * SC_C + (sl)) * 64); O.w1 = *(const f32x4*)(Lb + (0 * SC_C + (sl)) * 64 + 4); O.a0 = *(const f32x4*)(Lb + (1 * SC_C + (sl)) * 64); O.a1 = *(const f32x4*)(Lb + (1 * SC_C + (sl)) * 64 + 4); \
        O.b0 = *(const f32x4*)(Lb + (2 * SC_C + (sl)) * 64); O.b1 = *(const f32x4*)(Lb + (2 * SC_C + (sl)) * 64 + 4); } while (0)
#define SC_LDB(O, sl) do { O.k0 = *(const f32x4*)(Lb + (3 * SC_C + (sl)) * 64); O.k1 = *(const f32x4*)(Lb + (3 * SC_C + (sl)) * 64 + 4); \
        O.r0 = *(const f32x4*)(Lb + (4 * SC_C + (sl)) * 64); O.r1 = *(const f32x4*)(Lb + (4 * SC_C + (sl)) * 64 + 4); O.v = Lv[(sl) * 64]; } while (0)
#define SC_LD(O, sl) do { SC_LDA(O, sl); SC_LDB(O, sl); } while (0)
#define LO2(x) __builtin_shufflevector(x, x, 0, 1)
#define HI2(x) __builtin_shufflevector(x, x, 2, 3)
        ScanOps o0, o1, o2; SC_LD(o0, 0); SC_LD(o1, 1);
        float ysel = 0.f, ypend = 0.f;
#define SC_STEP(cur, ld, u) do { \
            f32x2 acc = s01 * LO2(cur.a0); acc = __builtin_elementwise_fma(s23, HI2(cur.a0), acc); acc = __builtin_elementwise_fma(s45, LO2(cur.a1), acc); acc = __builtin_elementwise_fma(s67, HI2(cur.a1), acc); \
            float t_ = acc.x + acc.y; \
            t_ += dppx<0xB1>(t_); ypend += dppx<0xB1>(ypend); t_ += dppx<0x4E>(t_); ypend += dppx<0x4E>(ypend); t_ += dppx<0x141>(t_); ypend += dppx<0x141>(ypend); \
            const float sa = t_; \
            if ((u) > 0) { ysel = (sub == (((u) - 1) & 7)) ? ypend : ysel; if ((((u) - 1) & 7) == 7) yb[((u) - 8 + sub) * 64 + row] = ysel; } \
            __builtin_amdgcn_sched_barrier(0); if ((u) + 2 < SC_C) SC_LDA(ld, (u) + 2); __builtin_amdgcn_sched_barrier(0); \
            const f32x2 sa2 = {sa, sa}, vi2 = {cur.v, cur.v}; \
            s01 = __builtin_elementwise_fma(LO2(cur.k0), vi2, __builtin_elementwise_fma(LO2(cur.b0), sa2, s01 * LO2(cur.w0))); \
            s23 = __builtin_elementwise_fma(HI2(cur.k0), vi2, __builtin_elementwise_fma(HI2(cur.b0), sa2, s23 * HI2(cur.w0))); \
            s45 = __builtin_elementwise_fma(LO2(cur.k1), vi2, __builtin_elementwise_fma(LO2(cur.b1), sa2, s45 * LO2(cur.w1))); \
            s67 = __builtin_elementwise_fma(HI2(cur.k1), vi2, __builtin_elementwise_fma(HI2(cur.b1), sa2, s67 * HI2(cur.w1))); \
            __builtin_amdgcn_sched_barrier(0); if ((u) + 2 < SC_C) SC_LDB(ld, (u) + 2); __builtin_amdgcn_sched_barrier(0); \
            f32x2 yy = s01 * LO2(cur.r0); yy = __builtin_elementwise_fma(s23, HI2(cur.r0), yy); yy = __builtin_elementwise_fma(s45, LO2(cur.r1), yy); yy = __builtin_elementwise_fma(s67, HI2(cur.r1), yy); \
            ypend = yy.x + yy.y;     \
            __builtin_amdgcn_sched_barrier(0); } while (0)
#define SC_STEP3(u) SC_STEP(o0, o2, u); SC_STEP(o1, o0, (u) + 1); SC_STEP(o2, o1, (u) + 2)
        SC_STEP3(0); SC_STEP3(3); SC_STEP3(6); SC_STEP3(9); SC_STEP3(12); SC_STEP3(15); SC_STEP3(18); SC_STEP3(21); SC_STEP3(24); SC_STEP3(27);
        SC_STEP(o0, o2, 30); SC_STEP(o1, o0, 31);
        { const float yl = red8(ypend); ysel = (sub == 7) ? yl : ysel; yb[(24 + sub) * 64 + row] = ysel; }
#undef SC_STEP3
#undef SC_STEP
#undef SC_LD
#undef SC_LDA
#undef SC_LDB
#undef LO2
#undef HI2
        if (n + 1 < NCH) SC_PREP((n + 1) & 1);
        __syncthreads();
    }
    SC_FLUSH(NCH - 1);
#undef SC_LOAD
#undef SC_PREP
#undef SC_FLUSH
}

struct P5In { f32x4 yf[2], yb[2]; u32x4 r[3][3]; u32x4 af, ab, z; };
__device__ __forceinline__ void unpack8h(u32x4 w, float* v) { v[0] = h2f((unsigned short)(w.x & 0xffffu)); v[1] = h2f((unsigned short)(w.x >> 16)); v[2] = h2f((unsigned short)(w.y & 0xffffu)); v[3] = h2f((unsigned short)(w.y >> 16));
    v[4] = h2f((unsigned short)(w.z & 0xffffu)); v[5] = h2f((unsigned short)(w.z >> 16)); v[6] = h2f((unsigned short)(w.w & 0xffffu)); v[7] = h2f((unsigned short)(w.w >> 16)); }
__device__ __forceinline__ void p5_load(P5In& in, int it, int c8, const float* __restrict__ yf, const float* __restrict__ yb, const bf16_t* __restrict__ rkv, const unsigned short* __restrict__ ua, const bf16_t* zb) {
    const int row = it >> 1, ch = (it & 1) * 512 + c8, t = row & (SEQ - 1);
    const float* yfp = yf + (size_t)row * 1024 + ch; const float* ybp = yb + (size_t)row * 1024 + ch;
    in.yf[0] = *(const f32x4*)yfp; in.yf[1] = *(const f32x4*)(yfp + 4); in.yb[0] = *(const f32x4*)ybp; in.yb[1] = *(const f32x4*)(ybp + 4);
    const bf16_t* base = rkv + (size_t)row * 3072 + ch; const bool hm = t > 0, hp = t < SEQ - 1;
#pragma unroll
    for (int sg = 0; sg < 3; ++sg) { in.r[sg][1] = *(const u32x4*)(base + sg * 1024);
        in.r[sg][0] = hm ? *(const u32x4*)(base + sg * 1024 - 3072) : (u32x4){0u, 0u, 0u, 0u}; in.r[sg][2] = hp ? *(const u32x4*)(base + sg * 1024 + 3072) : (u32x4){0u, 0u, 0u, 0u}; }
    const unsigned short* ub = ua + (size_t)row * 4096 + 2048 + ch; in.af = *(const u32x4*)ub; in.ab = *(const u32x4*)(ub + 1024);
    in.z = *(const u32x4*)(zb + (size_t)row * 2048 + 1024 + ch);
}
struct P5Par { float mur[8], muk[8], muv[8], ka[8], rk[8], gg[8], gb[8]; };
__device__ __forceinline__ void p5_finish(const P5In& in, int it, int c8, const P5Par& pp, bf16_t* zb) {
    const int row = it >> 1, ch = (it & 1) * 512 + c8;
    float y[8], sy = 0.f;
#pragma unroll
    for (int e = 0; e < 8; ++e) { y[e] = in.yf[e >> 2][e & 3] + in.yb[e >> 2][e & 3]; sy += y[e]; }
    const float mean = red8(sy) * (1.f / 64.f); float sv = 0.f;
#pragma unroll
    for (int e = 0; e < 8; ++e) { y[e] -= mean; sv += y[e] * y[e]; }
    const float rstd = rsqrtf(red8(sv) * (1.f / 64.f) + 64e-5f);
    float rr[3][3][8];
#pragma unroll
    for (int sg = 0; sg < 3; ++sg)
#pragma unroll
        for (int d = 0; d < 3; ++d) unpack8(in.r[sg][d], rr[sg][d]);
    float af[8], ab[8], zz[8], vv[8], sb = 0.f; unpack8h(in.af, af); unpack8h(in.ab, ab); unpack8(in.z, zz);
#pragma unroll
    for (int e = 0; e < 8; ++e) { const float r = rr[0][1][e] + pp.mur[e] * (0.5f * (rr[0][0][e] + rr[0][2][e]) - rr[0][1][e]), k = rr[1][1][e] + pp.muk[e] * (0.5f * (rr[1][0][e] + rr[1][2][e]) - rr[1][1][e]);
        vv[e] = rr[2][1][e] + pp.muv[e] * (0.5f * (rr[2][0][e] + rr[2][2][e]) - rr[2][1][e]);
        sb += r * (k * (2.f + (af[e] + ab[e] - 2.f) * pp.ka[e])) * pp.rk[e]; }
    const float bon = red8(sb);
    float o[8];
#pragma unroll
    for (int e = 0; e < 8; ++e) o[e] = (y[e] * rstd * pp.gg[e] + pp.gb[e] + bon * vv[e]) * zz[e];
    *(u32x4*)(zb + (size_t)row * 2048 + 1024 + ch) = pack8(o);
}

constexpr int T_IN = (NP1 / 64) * 32, T_Q = 24 * 8, T_KV = 32 * 8, T_BM = 32 * 16, T_OUT = 32 * 32, T_REST = T_Q + T_KV + 2 * T_BM + T_OUT;
constexpr int LDS_PHASE_BYTES = 139264;
#define XB_TMO      128
#define XB_XCNT(j)  (256  + 64 * (j))
#define XB_XSUB(j)  (1280 + 64 * (j))
#define XB_XGEN(j)  (2304 + 64 * (j))
#define XB_TOP      3328
#define XB_TOPGEN   3392
#define XCD_BAR_WORDS 3456
#define XB_SPIN_CAP (1u << 20)
__device__ __forceinline__ unsigned xb_ld(unsigned* p)              { return __hip_atomic_load(p, __ATOMIC_RELAXED, __HIP_MEMORY_SCOPE_AGENT); }
__device__ __forceinline__ unsigned xb_add(unsigned* p, unsigned v) { return __hip_atomic_fetch_add(p, v, __ATOMIC_RELAXED, __HIP_MEMORY_SCOPE_AGENT); }
__device__ __forceinline__ unsigned xb_xcc_id() { return (unsigned)__builtin_amdgcn_s_getreg((3 << 11) | 20) & 0xFu; }
#define XB_SPIN(cond, bar) do { unsigned _sp = 0; while (cond) { __builtin_amdgcn_s_sleep(1); \
    if ((++_sp & 255u) == 0u) { if (xb_ld(&(bar)[XB_TMO])) break; if (_sp > XB_SPIN_CAP) { atomicAdd(&(bar)[XB_TMO], 1u); break; } } } } while (0)
__device__ __forceinline__ void xcd_barrier_complete(unsigned* bar, unsigned x, unsigned G, unsigned& nloc, unsigned& nx) {
    unsigned sum, cnt, mine, sp = 0u;
    for (;;) {
        sum = 0u; cnt = 0u; mine = 0u;
#pragma unroll
        for (unsigned j = 0; j < 16; ++j) { const unsigned c = xb_ld(&bar[XB_XCNT(j)]); sum += c; cnt += (c > 0u) ? 1u : 0u; mine = (j == x) ? c : mine; }
        if (sum == G) break;
        __builtin_amdgcn_s_sleep(1);
        if ((++sp & 255u) == 0u) { if (xb_ld(&bar[XB_TMO])) break; if (sp > XB_SPIN_CAP) { atomicAdd(&bar[XB_TMO], 1u); break; } }
    }
    nloc = mine > 0u ? mine : 1u; nx = cnt > 0u ? cnt : 1u;
}
__device__ __forceinline__ void grid_barrier(unsigned* bar, volatile __attribute__((address_space(3))) unsigned* st, unsigned G, int tid) {
    asm volatile("s_waitcnt vmcnt(0)" ::: "memory");
    __syncthreads();
    if (tid == 0) {
        __builtin_amdgcn_s_waitcnt(0);
        const unsigned x = xb_xcc_id();
        unsigned nloc = st[0], nx = st[1];
        if (nloc == 0u) { xcd_barrier_complete(bar, x, G, nloc, nx); st[0] = nloc; st[1] = nx; }
        const unsigned old = xb_add(&bar[XB_XSUB(x)], 1u);
        const unsigned gen = old / nloc;
        if (old + 1u == (gen + 1u) * nloc) {
            __builtin_amdgcn_fence(__ATOMIC_RELEASE, "agent");
            asm volatile("s_waitcnt vmcnt(0)" ::: "memory");
            const unsigned og = xb_add(&bar[XB_TOP], 1u);
            const unsigned tg = og / nx;
            if (og + 1u == (tg + 1u) * nx) xb_add(&bar[XB_TOPGEN], 1u);
            else XB_SPIN(xb_ld(&bar[XB_TOPGEN]) == tg, bar);
            __builtin_amdgcn_fence(__ATOMIC_ACQUIRE, "agent");
            xb_add(&bar[XB_XGEN(x)], 1u);
            asm volatile("s_waitcnt vmcnt(0)" ::: "memory");
        } else {
            XB_SPIN(xb_ld(&bar[XB_XGEN(x)]) == gen, bar);
            __builtin_amdgcn_fence(__ATOMIC_ACQUIRE, "agent");
            asm volatile("s_waitcnt vmcnt(0)" ::: "memory");
        }
    }
    __syncthreads();
}
typedef const __attribute__((address_space(4))) Params* KP;
__device__ __forceinline__ Params load_params(KP kp) {
#if defined(__HIP_DEVICE_COMPILE__)
    return *kp;
#else
    return Params{};
#endif
}
#define PH_HEADER() \
        KP kp = (KP)__builtin_amdgcn_kernarg_segment_ptr(); asm volatile("" : "+s"(kp)); Params p = load_params(kp); \
         \
        unsigned char* ws = p.ws; asm volatile("" : "+s"(ws)); int tid = wid_s * 64 + (int)__builtin_amdgcn_mbcnt_hi(~0u, __builtin_amdgcn_mbcnt_lo(~0u, 0u)); asm volatile("" : "+v"(tid)); \
        const int wid = tid >> 6, lane = tid & 63, gw = bid * 8 + wid, NGW = G * 8; \
        bf16_t* W_in = (bf16_t*)(ws + WS_WIN); bf16_t* W_q = (bf16_t*)(ws + WS_WQ); bf16_t* W_kv = (bf16_t*)(ws + WS_WKV); bf16_t* W_lw = (bf16_t*)(ws + WS_LW); bf16_t* W_la = (bf16_t*)(ws + WS_LA); \
        bf16_t* W_bm = (bf16_t*)(ws + WS_WBM); bf16_t* W_br = (bf16_t*)(ws + WS_WBR); bf16_t* W_out = (bf16_t*)(ws + WS_WOUT); \
        float* cs = (float*)(ws + WS_CS); float* ssq = (float*)(ws + WS_SSQ); \
        bf16_t* hbuf = (bf16_t*)(ws + WS_H); bf16_t* qa = (bf16_t*)(ws + WS_QA); bf16_t* kva = (bf16_t*)(ws + WS_KVA); bf16_t* misc = (bf16_t*)(ws + WS_MISC); bf16_t* krope = (bf16_t*)(ws + WS_KROPE); \
        bf16_t* rkv = (bf16_t*)(ws + WS_RKV); bf16_t* zb = (bf16_t*)(ws + WS_Z); bf16_t* gb = (bf16_t*)p.out; bf16_t* qb = (bf16_t*)(ws + WS_Q); bf16_t* kvb = (bf16_t*)(ws + WS_KV); \
        bf16_t* Aw = (bf16_t*)(ws + WS_AW); bf16_t* Aa = (bf16_t*)(ws + WS_AA); unsigned short* ua = (unsigned short*)(ws + WS_UA); \
        float* tmp = (float*)(ws + WS_TMP); bf16_t* merged = (bf16_t*)(ws + WS_MERGED); \
        PG8_LAS unsigned char* glds = (PG8_LAS unsigned char*)shm; \
        pg8::StaticOrder S;
__global__ void __launch_bounds__(512) hybrid_fwd(Params p_arg) {
    extern __shared__ __attribute__((aligned(16))) char shm[];
    cg::grid_group grid = cg::this_grid();
    const int G = gridDim.x, bid = blockIdx.x;
    const int wid_s = __builtin_amdgcn_readfirstlane((int)threadIdx.x >> 6);
    const int ph_lo = p_arg.ph_lo, ph_hi = p_arg.ph_hi;
    volatile __attribute__((address_space(3))) unsigned* xb_st = (volatile __attribute__((address_space(3))) unsigned*)(shm + LDS_PHASE_BYTES);
    if (ph_hi - ph_lo > 1) {
        if (threadIdx.x == 0) { xb_st[0] = 0u; xb_st[1] = 0u; (void)xb_add((unsigned*)(p_arg.ws + WS_BAR) + XB_XCNT(xb_xcc_id()), 1u); }
        grid.sync();
    }
        if (PHEN(0) && ph_lo <= 0 && 0 < ph_hi) { PH_HEADER();
        for (int rep_ = 0; rep_ < DBLN(0); ++rep_) {
            for (int it = bid; it < T_IN; it += G) transpose_tile(p.w_in, DIN, 2048, W_in, 1, nullptr, it, (float*)shm, tid);
            for (int i = bid * 512 + tid; i < 2 * 2048 * 32; i += G * 512) { const int which = i >> 16, rem = i & 65535, kg = rem >> 11, n = rem & 2047, k0 = kg * 8;
                float v[8] = {0.f, 0.f, 0.f, 0.f, 0.f, 0.f, 0.f, 0.f}; const float* sp = nullptr;
                if (n < 1024) { if (k0 < 96) sp = (which ? p.a2_f : p.w2_f) + (size_t)k0 * 1024 + n; } else { if (k0 >= 128 && k0 < 224) sp = (which ? p.a2_b : p.w2_b) + (size_t)(k0 - 128) * 1024 + (n - 1024); }
                if (sp) {
#pragma unroll
                    for (int e = 0; e < 8; ++e) v[e] = sp[(size_t)e * 1024]; }
                *(u32x4*)((which ? W_la : W_lw) + (size_t)n * 256 + k0) = pack8(v); }
            for (int i = bid * 512 + tid; i < SEQ * 32; i += G * 512) { const int pos = i >> 5, fi = i & 31; const float inv = exp2f(-(float)fi * (13.287712379549449f / 32.f)); const float ang = (float)pos * inv;
                double rev = (double)ang * 0.15915494309189535; rev -= floor(rev); const float rf = (float)rev;
                cs[2 * i] = __builtin_amdgcn_cosf(rf); cs[2 * i + 1] = __builtin_amdgcn_sinf(rf); }
            f32x4 gpre[4][2];
#pragma unroll
            for (int j = 0; j < 4; ++j)
#pragma unroll
                for (int hh = 0; hh < 2; ++hh) gpre[j][hh] = *(const f32x4*)(p.g_pre + (j * 64 + lane) * 8 + hh * 4);
            for (int row = gw; row < T; row += NGW) { const float* xr = p.x + (size_t)row * DM; f32x4 v[4][2]; float s = 0.f;
#pragma unroll
                for (int j = 0; j < 4; ++j)
#pragma unroll
                    for (int hh = 0; hh < 2; ++hh) { v[j][hh] = *(const f32x4*)(xr + (j * 64 + lane) * 8 + hh * 4); s += (v[j][hh][0] * v[j][hh][0] + v[j][hh][1] * v[j][hh][1]) + (v[j][hh][2] * v[j][hh][2] + v[j][hh][3] * v[j][hh][3]); }
                const float rs = rsqrtf(wave_sum_fast(s) * (1.f / DM) + 1e-6f);
#pragma unroll
                for (int j = 0; j < 4; ++j) { float o[8];
#pragma unroll
                    for (int e = 0; e < 4; ++e) { o[e] = v[j][0][e] * rs * gpre[j][0][e]; o[4 + e] = v[j][1][e] * rs * gpre[j][1][e]; }
                    *(u32x4*)(hbuf + (size_t)row * DM + (j * 64 + lane) * 8) = pack8(o); } }

        } }
        if (PHEN(1) && ph_lo <= 1 && 1 < ph_hi) { PH_HEADER(); if (1 > ph_lo) grid_barrier((unsigned*)(ws + WS_BAR), xb_st, (unsigned)G, tid);
        for (int rep_ = 0; rep_ < DBLN(1); ++rep_) {
            S.init(T, NP1, G, bid); Epi1 E{qa, kva, misc, krope, rkv, zb, gb, ssq, cs};
            pg8::gemm_phase(glds, pg8::Gemm{hbuf, W_in, T, NP1, 2048, 2048, 2048}, S, E, tid);
            if (bid >= G / 2) for (int it = bid - G / 2; it < T_REST; it += G - G / 2) { int r = it; float* tl = (float*)shm;
                if (r < T_Q) { transpose_tile(p.wq_b, 1536, 512, W_q, 2, p.q_norm, r, tl, tid); continue; } r -= T_Q;
                if (r < T_KV) { transpose_tile(p.wkv_b, 2048, 512, W_kv, 0, p.kv_norm, r, tl, tid); continue; } r -= T_KV;
                if (r < T_BM) { transpose_tile(p.w_br_mla, 2048, 1024, W_bm, 0, nullptr, r, tl, tid, 2048); continue; } r -= T_BM;
                if (r < T_BM) { transpose_tile(p.w_br_rwkv, 2048, 1024, W_bm + 1024, 0, nullptr, r, tl, tid, 2048); continue; } r -= T_BM;
                transpose_tile(p.w_out, 2048, 2048, W_out, 0, nullptr, r, tl, tid); }

        } }
        if (PHEN(2) && ph_lo <= 2 && 2 < ph_hi) { PH_HEADER(); if (2 > ph_lo) grid_barrier((unsigned*)(ws + WS_BAR), xb_st, (unsigned)G, tid);
        for (int rep_ = 0; rep_ < DBLN(2); ++rep_) {
            { S.init(T, 1536, G, bid); EpiQ E{qb, ssq, cs}; pg8::gemm_phase(glds, pg8::Gemm{qa, W_q, T, 1536, 512, 512, 512}, S, E, tid); }
            { S.init(T, 2048, G, bid); EpiKV E{kvb, ssq}; pg8::gemm_phase(glds, pg8::Gemm{kva, W_kv, T, 2048, 512, 512, 512}, S, E, tid); }
            { const int c = tid & 63, isA = c >> 5, cc = (c & 31) * 8, half = cc >> 7, kc = cc & 127;
              const bool live = kc < 96; const int mcol = 64 + isA * 192 + half * 96 + kc;
              float mu8[8];
#pragma unroll
              for (int e = 0; e < 8; ++e) mu8[e] = live ? p.mu[3072 + isA * 192 + half * 96 + kc + e] : 0.f;
              bf16_t* dstb = (isA ? Aa : Aw) + cc;
              for (int row = bid * 8 + (tid >> 6); row < T; row += G * 8) { const int t = row & (SEQ - 1); u32x4 outv = {0u, 0u, 0u, 0u};
                  if (live) { const bf16_t* mp = misc + (size_t)row * 512 + mcol; float o[8], x0[8], xm[8], xp[8];
                      unpack8(*(const u32x4*)mp, x0); unpack8(t > 0 ? *(const u32x4*)(mp - 512) : (u32x4){0u, 0u, 0u, 0u}, xm); unpack8(t < SEQ - 1 ? *(const u32x4*)(mp + 512) : (u32x4){0u, 0u, 0u, 0u}, xp);
#pragma unroll
                      for (int e = 0; e < 8; ++e) { const float xs = x0[e] + mu8[e] * (0.5f * (xm[e] + xp[e]) - x0[e]); o[e] = isA ? xs : 1.f - 2.f * __builtin_amdgcn_rcpf(1.f + __expf(2.f * xs)); }
                      outv = pack8(o); }
                  *(u32x4*)(dstb + (size_t)row * 256) = outv; } }

        } }
        if (PHEN(3) && ph_lo <= 3 && 3 < ph_hi) { PH_HEADER(); if (3 > ph_lo) grid_barrier((unsigned*)(ws + WS_BAR), xb_st, (unsigned)G, tid);
            for (int i = 0; i * G + bid < 512; ++i) { const int L = i * G + bid; int b, h, qblk;
                if (G == 256) { const int xcd = bid & 7, sI = bid >> 3, idx = i * 32 + sI, pl = idx >> 3; qblk = idx & 7; const int pair = pl * 8 + xcd; b = pair >> 3; h = pair & 7; }
                else { qblk = L & 7; h = (L >> 3) & 7; b = L >> 6; }
                const size_t tok0 = (size_t)b * SEQ;
                att::attn_body(qb + (tok0 + qblk * 256) * 1536 + h * 192, kvb + tok0 * 2048 + h * 256, kvb + tok0 * 2048 + h * 256 + 128, krope + tok0 * 64,
                               zb + (tok0 + qblk * 256) * 2048 + h * 128, SEQ, shm, tid); }
            __syncthreads();
#ifndef NO_LORA
            { S.init(T, 2048, G, bid); EpiLora E{ua, 0, p.w0_f, p.w0_b}; pg8::gemm_phase(glds, pg8::Gemm{Aw, W_lw, T, 2048, 256, 256, 256}, S, E, tid); }
            { S.init(T, 2048, G, bid); EpiLora E{ua, 2048, p.a0_f, p.a0_b}; pg8::gemm_phase(glds, pg8::Gemm{Aa, W_la, T, 2048, 256, 256, 256}, S, E, tid); }
#endif
        }
        if (PHEN(4) && ph_lo <= 4 && 4 < ph_hi) { PH_HEADER(); if (4 > ph_lo) grid_barrier((unsigned*)(ws + WS_BAR), xb_st, (unsigned)G, tid);
        for (int rep_ = 0; rep_ < DBLN(4); ++rep_) {
            for (int c = bid; c < 256; c += G) scan_chain(p, c, shm, tid);

        } }
        if (PHEN(5) && ph_lo <= 5 && 5 < ph_hi) { PH_HEADER(); if (5 > ph_lo) grid_barrier((unsigned*)(ws + WS_BAR), xb_st, (unsigned)G, tid);
            const float* __restrict__ yf = (const float*)(ws + WS_YF); const float* __restrict__ yb = (const float*)(ws + WS_YB);
            const int c8 = lane * 8;
            P5Par pp; { const int chq = (gw & 1) * 512 + c8;
#pragma unroll
                for (int e = 0; e < 8; ++e) { pp.mur[e] = p.mu[chq + e]; pp.muk[e] = p.mu[1024 + chq + e]; pp.muv[e] = p.mu[2048 + chq + e]; pp.ka[e] = p.k_a[chq + e]; pp.rk[e] = p.r_k[chq + e]; pp.gg[e] = p.gn_g[chq + e]; pp.gb[e] = p.gn_b[chq + e]; } }
            for (int it = gw; it < T * 2; it += NGW) {
                P5In in; p5_load(in, it, c8, yf, yb, rkv, ua, zb); p5_finish(in, it, c8, pp, zb);
            }
        }
        if (PHEN(6) && ph_lo <= 6 && 6 < ph_hi) { PH_HEADER(); if (6 > ph_lo) grid_barrier((unsigned*)(ws + WS_BAR), xb_st, (unsigned)G, tid);
        for (int rep_ = 0; rep_ < DBLN(6); ++rep_) {
            { S.init(T, 2048, G, bid); EpiMerge E{gb, merged}; pg8::gemm_phase(glds, pg8::Gemm{zb, W_bm, T, 2048, 2048, 2048, 2048}, S, E, tid); }

        } }
        if (PHEN(7) && ph_lo <= 7 && 7 < ph_hi) { PH_HEADER(); if (7 > ph_lo) grid_barrier((unsigned*)(ws + WS_BAR), xb_st, (unsigned)G, tid);
        for (int rep_ = 0; rep_ < DBLN(7); ++rep_) {
            S.init(T, 2048, G, bid); EpiOut E{(bf16_t*)(ws + WS_ORAW)}; pg8::gemm_phase(glds, pg8::Gemm{merged, W_out, T, 2048, 2048, 2048, 2048}, S, E, tid);

        } }
        if (PHEN(8) && ph_lo <= 8 && 8 < ph_hi) { PH_HEADER(); if (8 > ph_lo) grid_barrier((unsigned*)(ws + WS_BAR), xb_st, (unsigned)G, tid);
            const bf16_t* oraw = (const bf16_t*)(ws + WS_ORAW);
            f32x4 gpost[4][2];
#pragma unroll
            for (int j = 0; j < 4; ++j)
#pragma unroll
                for (int hh = 0; hh < 2; ++hh) gpost[j][hh] = *(const f32x4*)(p.g_post + (j * 64 + lane) * 8 + hh * 4);
            for (int row = gw; row < T; row += NGW) { float* orow = p.out + (size_t)row * DM; const float* xr = p.x + (size_t)row * DM; float v[4][8]; float s = 0.f;
                u32x4 ow[4]; f32x4 xx[4][2];
#pragma unroll
                for (int j = 0; j < 4; ++j) { ow[j] = *(const u32x4*)(oraw + (size_t)row * DM + (j * 64 + lane) * 8);
#pragma unroll
                    for (int hh = 0; hh < 2; ++hh) xx[j][hh] = *(const f32x4*)(xr + (j * 64 + lane) * 8 + hh * 4); }
#pragma unroll
                for (int j = 0; j < 4; ++j) { unpack8(ow[j], v[j]);
#pragma unroll
                    for (int e = 0; e < 8; ++e) s += v[j][e] * v[j][e]; }
                const float rs = rsqrtf(wave_sum_fast(s) * (1.f / DM) + 1e-6f);
#pragma unroll
                for (int j = 0; j < 4; ++j) { const int c = (j * 64 + lane) * 8;
#pragma unroll
                    for (int hh = 0; hh < 2; ++hh) { const f32x4 gg = gpost[j][hh], xv = xx[j][hh];
                        *(f32x4*)(orow + c + hh * 4) = (f32x4){xv[0] + v[j][hh * 4 + 0] * rs * gg[0], xv[1] + v[j][hh * 4 + 1] * rs * gg[1], xv[2] + v[j][hh * 4 + 2] * rs * gg[2], xv[3] + v[j][hh * 4 + 3] * rs * gg[3]}; } } }
        }
}

constexpr int LDS_BYTES = LDS_PHASE_BYTES + 16;
constexpr int NPH = 9;
extern "C" void kernel_launch(void* const* d_in, const int* in_sizes, int n_in, void* d_out, int out_size, void* d_ws, size_t ws_size, hipStream_t stream) {
    static int grid = 0;
    if (grid == 0) {
        if (n_in != 25 || out_size != T * DM || ws_size < WS_END) { fprintf(stderr, "kernel_launch: shape mismatch n_in %d out %d ws %zu (need %zu)\n", n_in, out_size, ws_size, (size_t)WS_END); grid = -1; return; }
        int dev = 0, cus = 0, per_cu = 0;
        if (hipGetDevice(&dev) != hipSuccess || hipDeviceGetAttribute(&cus, hipDeviceAttributeMultiprocessorCount, dev) != hipSuccess) { grid = -1; return; }
        if (hipFuncSetAttribute((const void*)hybrid_fwd, hipFuncAttributeMaxDynamicSharedMemorySize, LDS_BYTES) != hipSuccess) { fprintf(stderr, "kernel_launch: hipFuncSetAttribute failed\n"); grid = -1; return; }
        if (hipOccupancyMaxActiveBlocksPerMultiprocessor(&per_cu, (const void*)hybrid_fwd, 512, LDS_BYTES) != hipSuccess || per_cu < 1) { fprintf(stderr, "kernel_launch: occupancy query says %d\n", per_cu); grid = -1; return; }
        grid = cus;
    }
    if (grid < 0) return;
    Params p{};
    const float** pp = (const float**)&p;
    for (int i = 0; i < 25; ++i) pp[i] = (const float*)d_in[i];
    p.out = (float*)d_out; p.ws = (unsigned char*)d_ws;
    if (hipMemsetAsync((char*)d_ws + WS_BAR, 0, 16384, stream) != hipSuccess) { fprintf(stderr, "kernel_launch: memset failed\n"); return; }
#if N_LAUNCHES == 1
    p.ph_lo = 0; p.ph_hi = NPH;
    void* args[] = {&p};
    hipError_t e = hipLaunchCooperativeKernel((const void*)hybrid_fwd, dim3(grid), dim3(512), args, LDS_BYTES, stream);
    if (e != hipSuccess) fprintf(stderr, "cooperative launch failed: %s (grid %d)\n", hipGetErrorString(e), grid);
#else
    for (int ph = 0; ph < NPH; ++ph) { p.ph_lo = ph; p.ph_hi = ph + 1; hipLaunchKernelGGL(hybrid_fwd, dim3(grid), dim3(512), LDS_BYTES, stream, p); }
#endif
}
```

```cpp
#include <hip/hip_runtime.h>
#include <hip/hip_cooperative_groups.h>
#include <cstdio>
#include <cstdint>
namespace cg = cooperative_groups;

#ifndef PH_MASK
#define PH_MASK 0x1ff
#endif
#define PHEN(i) ((PH_MASK >> (i)) & 1)
#ifndef DBL_MASK
#define DBL_MASK 0
#endif
#define DBLN(i) (1 + ((DBL_MASK >> (i)) & 1))
#ifndef N_LAUNCHES
#define N_LAUNCHES 1
#endif

constexpr int T = 16384, SEQ = 2048, DM = 2048, DIN = 10688;
constexpr int NP1 = 10752;
constexpr size_t MiB = 1u << 20;
constexpr size_t WS_WQ = 0, WS_WKV = WS_WQ + 1536 * 512 * 2, WS_LW = WS_WKV + 2048 * 512 * 2, WS_LA = WS_LW + 2048 * 256 * 2, WS_WBM = WS_LA + 2048 * 256 * 2,
                 WS_WBR = WS_WBM + 2048 * 1024 * 2, WS_WOUT = WS_WBR + 2048 * 1024 * 2, WS_CS = WS_WOUT + 2048 * 2048 * 2, WS_SSQ = WS_CS + 2048 * 32 * 8,
                 WS_SMALL_END = WS_SSQ + (size_t)T * 16 * 4;
static_assert(WS_SMALL_END <= 23 * MiB, "small region");
constexpr size_t WS_RKV = 23 * MiB, WS_Z = 119 * MiB, WS_KROPE = 183 * MiB, WS_H = 185 * MiB  , WS_Q = WS_H, WS_AW = 233 * MiB, WS_AA = 241 * MiB,
                 WS_KV = 249 * MiB  , WS_WIN = 313 * MiB, WS_QA = 355 * MiB, WS_KVA = 371 * MiB, WS_MISC = 387 * MiB, WS_UA = 313 * MiB  ,
                 WS_YF = 185 * MiB, WS_YB = 249 * MiB, WS_TMP = 313 * MiB, WS_MERGED = 185 * MiB, WS_ORAW = 313 * MiB  , WS_BAR = 441 * MiB, WS_END = 441 * MiB + 16384;

typedef unsigned short bf16_t;
typedef short bf16x8 __attribute__((ext_vector_type(8)));
typedef short s16x4 __attribute__((ext_vector_type(4)));
typedef float f32x4 __attribute__((ext_vector_type(4)));
typedef float f32x16 __attribute__((ext_vector_type(16)));
typedef unsigned u32x4 __attribute__((ext_vector_type(4)));
typedef float f32x2 __attribute__((ext_vector_type(2)));

struct Params {
    const float *x, *g_pre, *w_in, *q_norm, *wq_b, *kv_norm, *wkv_b, *mu, *w0_f, *w2_f, *w0_b, *w2_b, *a0_f, *a2_f, *a0_b, *a2_b, *k_k, *k_a, *r_k, *gn_g, *gn_b, *w_br_mla, *w_br_rwkv, *w_out, *g_post;
    float* out; unsigned char* ws; int ph_lo, ph_hi;
};

__device__ __forceinline__ unsigned cvt_pk_bf16(float lo, float hi) { unsigned r; asm volatile("v_cvt_pk_bf16_f32 %0, %1, %2" : "=v"(r) : "v"(lo), "v"(hi)); return r; }
__device__ __forceinline__ float bf2f(bf16_t b) { return __uint_as_float(((unsigned)b) << 16); }
__device__ __forceinline__ bf16_t f2bf(float f) { return (bf16_t)(cvt_pk_bf16(f, 0.f) & 0xffffu); }
__device__ __forceinline__ float h2f(unsigned short h) { _Float16 v; __builtin_memcpy(&v, &h, 2); return (float)v; }
__device__ __forceinline__ unsigned pk_f16(float a, float b) { _Float16 x = (_Float16)a, y = (_Float16)b; unsigned short xs, ys; __builtin_memcpy(&xs, &x, 2); __builtin_memcpy(&ys, &y, 2); return (unsigned)xs | ((unsigned)ys << 16); }
__device__ __forceinline__ float sigmoidf_(float v) { return __builtin_amdgcn_rcpf(1.f + __expf(-v)); }
__device__ __forceinline__ float wave_sum(float v) {
#pragma unroll
    for (int o = 1; o < 64; o <<= 1) v += __shfl_xor(v, o);
    return v;
}
template <int CTRL> __device__ __forceinline__ float dppx(float v) { return __int_as_float(__builtin_amdgcn_update_dpp(0, __float_as_int(v), CTRL, 0xF, 0xF, true)); }
__device__ __forceinline__ float red8(float v) { v += dppx<0xB1>(v); v += dppx<0x4E>(v); v += dppx<0x141>(v); return v; }
__device__ __forceinline__ float red16(float v) { v = red8(v); v += dppx<0x140>(v); return v; }
__device__ __forceinline__ float wave_sum_fast(float v) { v = red16(v); const int iv = __float_as_int(v);
    return (__int_as_float(__builtin_amdgcn_readlane(iv, 0)) + __int_as_float(__builtin_amdgcn_readlane(iv, 16))) + (__int_as_float(__builtin_amdgcn_readlane(iv, 32)) + __int_as_float(__builtin_amdgcn_readlane(iv, 48))); }
typedef unsigned u32x2 __attribute__((ext_vector_type(2)));
__device__ __forceinline__ void unpack4(u32x2 w, float* v) { v[0] = __uint_as_float(w.x << 16); v[1] = __uint_as_float(w.x & 0xffff0000u); v[2] = __uint_as_float(w.y << 16); v[3] = __uint_as_float(w.y & 0xffff0000u); }
__device__ __forceinline__ void unpack4h(u32x2 w, float* v) { v[0] = h2f((unsigned short)(w.x & 0xffffu)); v[1] = h2f((unsigned short)(w.x >> 16)); v[2] = h2f((unsigned short)(w.y & 0xffffu)); v[3] = h2f((unsigned short)(w.y >> 16)); }
__device__ __forceinline__ u32x4 pack8(const float* v) { u32x4 w; w.x = cvt_pk_bf16(v[0], v[1]); w.y = cvt_pk_bf16(v[2], v[3]); w.z = cvt_pk_bf16(v[4], v[5]); w.w = cvt_pk_bf16(v[6], v[7]); return w; }
__device__ __forceinline__ void unpack8(u32x4 w, float* v) {
    v[0] = __uint_as_float(w.x << 16); v[1] = __uint_as_float(w.x & 0xffff0000u); v[2] = __uint_as_float(w.y << 16); v[3] = __uint_as_float(w.y & 0xffff0000u);
    v[4] = __uint_as_float(w.z << 16); v[5] = __uint_as_float(w.z & 0xffff0000u); v[6] = __uint_as_float(w.w << 16); v[7] = __uint_as_float(w.w & 0xffff0000u);
}

namespace pg8 {
#define PG8_LAS __attribute__((address_space(3)))
constexpr int BM = 256, BK = 64, HALF = 128, HTB = HALF * BK * 2, STAGE_BYTES = 8 * HTB, NXCD = 8, WGM = 8;
__host__ __device__ __forceinline__ int lds_byte(int r, int c) { const int st = (r >> 4) * 2 + (c >> 5), rr = r & 15, cc = c & 31, ob = rr * 64 + cc * 2; return st * 1024 + (ob ^ (((ob >> 9) & 1) << 5)); }
__host__ __device__ __forceinline__ void stage_rc(int b, int& R, int& C) { const int st = b / 1024, sb = b % 1024, swz = sb ^ (((sb >> 9) & 1) << 5); R = (st >> 1) * 16 + swz / 64; C = (st & 1) * 32 + (swz % 64) / 2; }
__host__ __device__ __forceinline__ int perm32(int rho) { const int n = rho >> 4, i = rho & 15; return 8 * (i >> 2) + 4 * n + (i & 3); }
struct Unit { int pm, pn; };
struct Gemm { const bf16_t* A; const bf16_t* Bt; int M, N, K, lda, ldb; };
struct StaticOrder {
    int nM, nN, nwg, G, c;
    __host__ __device__ void init(int M, int N, int G_, int c_) { nM = M / BM; nN = N / BM; nwg = nM * nN; G = G_; c = c_; }
    __host__ __device__ bool next(int i, Unit& u) const {
        const long L = (long)i * G + c; if (L >= nwg) return false;
        int wgid = (int)L; { const int q = nwg / NXCD, r = nwg % NXCD, xcd = wgid % NXCD, off = wgid / NXCD; wgid = (xcd < r ? xcd * (q + 1) : r * (q + 1) + (xcd - r) * q) + off; }
        const int nig = WGM * nN, gid = wgid / nig, fm = gid * WGM, gsz = (nM - fm) < WGM ? (nM - fm) : WGM;
        u.pm = fm + ((wgid % nig) % gsz); u.pn = (wgid % nig) / gsz; return true;
    }
    __device__ __forceinline__ void a_ready(const Unit&) const {}
    __device__ __forceinline__ void done(const Unit&) const {}
};
template <class Epi, class Sched>
__device__ __forceinline__ void gemm_phase(PG8_LAS unsigned char* lds, const Gemm g, const Sched& S, const Epi& E, int tid_in) {
    int tid_l = tid_in; asm volatile("" : "+v"(tid_l));
    const int tid = tid_l, wid = __builtin_amdgcn_readfirstlane(tid >> 6), lane = tid & 63, wr = wid >> 2, wc = wid & 3, fr = lane & 15, fq = lane >> 4;
    const int K = g.K, nt = K / BK;
    unsigned voffA[2], voffB[2];
#pragma unroll
    for (int i = 0; i < 2; ++i) { int R, C; stage_rc(tid * 16 + i * 8192, R, C); const int Rb = Epi::PERM ? ((R & ~31) + perm32(R & 31)) : R;
        voffA[i] = (unsigned)(R * g.lda + C) * 2u; voffB[i] = (unsigned)(Rb * g.ldb + C) * 2u; }
    const size_t kstep = (size_t)(BK * 2);
    const size_t hstepA = (size_t)HALF * g.lda * 2, hstepB = (size_t)HALF * g.ldb * 2;
    const size_t tstepA = 2 * hstepA, tstepB = 2 * hstepB;
    const unsigned ldsw = (unsigned)wid * 1024u;
    const int aoff = lds_byte(wr * 64 + fr, fq * 8), boff = lds_byte(wc * 32 + fr, fq * 8);
#define PG8_SA(b, h) (((b) * 2 + (h)) * HTB)
#define PG8_SB(b, h) ((4 + (b) * 2 + (h)) * HTB)
#define PG8_STAGE(bufoff, gbase, voff) do { _Pragma("unroll") for (int _i = 0; _i < 2; ++_i) \
        __builtin_amdgcn_global_load_lds((const unsigned*)((const char*)(gbase) + (voff)[_i]), (PG8_LAS unsigned*)(lds + (bufoff) + ldsw + _i * 8192), 16, 0, 0); } while (0)
#define PG8_LDA(dst, b, h) do { _Pragma("unroll") for (int m = 0; m < 4; ++m) _Pragma("unroll") for (int k = 0; k < 2; ++k) dst[m][k] = *(const PG8_LAS bf16x8*)(lds + PG8_SA(b, h) + aoff + m * 2048 + k * 1024); } while (0)
#define PG8_LDB(dst, b, h) do { _Pragma("unroll") for (int n = 0; n < 2; ++n) _Pragma("unroll") for (int k = 0; k < 2; ++k) dst[n][k] = *(const PG8_LAS bf16x8*)(lds + PG8_SB(b, h) + boff + n * 2048 + k * 1024); } while (0)
#define PG8_MMA(ai, bj, At, Bt) do { __builtin_amdgcn_s_setprio(1); _Pragma("unroll") for (int m = 0; m < 4; ++m) _Pragma("unroll") for (int n = 0; n < 2; ++n) _Pragma("unroll") for (int k = 0; k < 2; ++k) \
        acc[ai][bj][m][n] = __builtin_amdgcn_mfma_f32_16x16x32_bf16(Bt[n][k], At[m][k], acc[ai][bj][m][n], 0, 0, 0); __builtin_amdgcn_s_setprio(0); } while (0)
#define PG8_WAIT_V(n) asm volatile("s_waitcnt vmcnt(" #n ")" ::: "memory")
#define PG8_WAIT_L(n) asm volatile("s_waitcnt lgkmcnt(" #n ")" ::: "memory")
#define PG8_BAR __builtin_amdgcn_s_barrier()
#define PG8_SCHED __builtin_amdgcn_sched_barrier(0)
    Unit cur, nxt; int ui = 0;
    if (!S.next(0, cur)) return;
    f32x4 acc[2][2][4][2];
#pragma unroll
    for (int a = 0; a < 2; ++a)
#pragma unroll
        for (int b = 0; b < 2; ++b)
#pragma unroll
            for (int m = 0; m < 4; ++m)
#pragma unroll
                for (int n = 0; n < 2; ++n) acc[a][b][m][n] = (f32x4){0.f, 0.f, 0.f, 0.f};
    bf16x8 At[4][2], B0[2][2], B1[2][2];
    const char* cA = (const char*)g.A + (size_t)cur.pm * tstepA; const char* cB = (const char*)g.Bt + (size_t)cur.pn * tstepB;
    S.a_ready(cur);
    PG8_STAGE(PG8_SB(0, 0), cB, voffB); PG8_STAGE(PG8_SA(0, 0), cA, voffA); PG8_STAGE(PG8_SB(0, 1), cB + hstepB, voffB); PG8_STAGE(PG8_SA(0, 1), cA + hstepA, voffA);
    if (wr == 1) PG8_BAR;
    PG8_WAIT_V(4); PG8_BAR;
    PG8_STAGE(PG8_SB(1, 0), cB + kstep, voffB); PG8_STAGE(PG8_SA(1, 0), cA + kstep, voffA); PG8_STAGE(PG8_SB(1, 1), cB + hstepB + kstep, voffB);
    PG8_WAIT_V(6); PG8_BAR;
    for (;;) {
        const bool has_next = S.next(ui + 1, nxt);
        const char* nA = has_next ? (const char*)g.A + (size_t)nxt.pm * tstepA : cA; const char* nB = has_next ? (const char*)g.Bt + (size_t)nxt.pn * tstepB : cB;
        for (int t = 0; t < nt; t += 2) {
            const bool last = (t == nt - 2);
            const char* a1 = cA + (size_t)(t + 1) * kstep;
            const char* a2 = last ? nA : cA + (size_t)(t + 2) * kstep; const char* b2 = last ? nB : cB + (size_t)(t + 2) * kstep;
            const char* a3 = a2 + kstep; const char* b3 = b2 + kstep;
            if (last && has_next) S.a_ready(nxt);
            if constexpr (Epi::MID) { if (t == (nt >> 1)) E.mid(acc, cur, wr, wc, fr, fq); }
            PG8_LDB(B0, 0, 0); PG8_SCHED; PG8_LDA(At, 0, 0); PG8_STAGE(PG8_SA(1, 1), a1 + hstepA, voffA);
            PG8_WAIT_L(8); PG8_BAR; PG8_WAIT_L(0); PG8_MMA(0, 0, At, B0); PG8_BAR; PG8_SCHED;
            PG8_LDB(B1, 0, 1); PG8_STAGE(PG8_SB(0, 0), b2, voffB);
            PG8_BAR; PG8_WAIT_L(0); PG8_MMA(0, 1, At, B1); PG8_BAR;
            PG8_LDA(At, 0, 1); PG8_STAGE(PG8_SA(0, 0), a2, voffA);
            PG8_BAR; PG8_WAIT_L(0); PG8_MMA(1, 0, At, B0); PG8_BAR; PG8_SCHED;
            PG8_STAGE(PG8_SB(0, 1), b2 + hstepB, voffB);
            PG8_WAIT_V(6); PG8_BAR; PG8_MMA(1, 1, At, B1); PG8_BAR;
            PG8_LDB(B0, 1, 0); PG8_SCHED; PG8_LDA(At, 1, 0); PG8_STAGE(PG8_SA(0, 1), a2 + hstepA, voffA);
            PG8_WAIT_L(8); PG8_BAR; PG8_WAIT_L(0); PG8_MMA(0, 0, At, B0); PG8_BAR; PG8_SCHED;
            PG8_LDB(B1, 1, 1); PG8_STAGE(PG8_SB(1, 0), b3, voffB);
            PG8_BAR; PG8_WAIT_L(0); PG8_MMA(0, 1, At, B1); PG8_BAR;
            PG8_LDA(At, 1, 1); PG8_STAGE(PG8_SA(1, 0), a3, voffA);
            PG8_BAR; PG8_WAIT_L(0); PG8_MMA(1, 0, At, B0); PG8_BAR; PG8_SCHED;
            PG8_STAGE(PG8_SB(1, 1), b3 + hstepB, voffB);
            PG8_WAIT_V(6); PG8_BAR; PG8_MMA(1, 1, At, B1); PG8_BAR;
        }
        E(acc, cur, wr, wc, fr, fq); S.done(cur);
        if (!has_next) break;
#pragma unroll
        for (int a = 0; a < 2; ++a)
#pragma unroll
            for (int b = 0; b < 2; ++b)
#pragma unroll
                for (int m = 0; m < 4; ++m)
#pragma unroll
                    for (int n = 0; n < 2; ++n) acc[a][b][m][n] = (f32x4){0.f, 0.f, 0.f, 0.f};
        cur = nxt; cA = nA; cB = nB; ++ui;
    }
    PG8_WAIT_V(0);
    if (wr == 0) PG8_BAR;
    PG8_BAR;
#undef PG8_SA
#undef PG8_SB
#undef PG8_STAGE
#undef PG8_LDA
#undef PG8_LDB
#undef PG8_MMA
#undef PG8_WAIT_V
#undef PG8_WAIT_L
#undef PG8_BAR
#undef PG8_SCHED
}
}
using pg8::Unit;
typedef const f32x4 (&AccRef)[2][2][4][2];

#define EPI_LOOP_ROWS _Pragma("unroll") for (int ai = 0; ai < 2; ++ai) _Pragma("unroll") for (int m = 0; m < 4; ++m)
#define EPI_GET8(v) float v[8]; { const f32x4 x0 = acc[ai][bj][m][0], x1 = acc[ai][bj][m][1]; v[0] = x0[0]; v[1] = x0[1]; v[2] = x0[2]; v[3] = x0[3]; v[4] = x1[0]; v[5] = x1[1]; v[6] = x1[2]; v[7] = x1[3]; }

__device__ __forceinline__ void rope8(float* v, const float* cs, int pos, int p0) {
    const f32x4 c0 = *(const f32x4*)(cs + ((size_t)pos * 32 + p0) * 2), c1 = *(const f32x4*)(cs + ((size_t)pos * 32 + p0 + 2) * 2);
    const float co[4] = {c0[0], c0[2], c1[0], c1[2]}, si[4] = {c0[1], c0[3], c1[1], c1[3]};
#pragma unroll
    for (int q = 0; q < 4; ++q) { const float a = v[2 * q], b = v[2 * q + 1]; v[2 * q] = a * co[q] - b * si[q]; v[2 * q + 1] = a * si[q] + b * co[q]; }
}

struct Epi1 {
    static constexpr bool PERM = true, MID = false;
    bf16_t *qa, *kva, *misc, *krope, *rkv, *z, *g; float* ssq; const float* cs;
    __device__ __forceinline__ void operator()(AccRef acc, const Unit& u, int wr, int wc, int fr, int fq) const {
        const int pn = u.pn, row0 = u.pm * 256 + wr * 64 + fr, cl = wc * 32 + 8 * fq;
        if (pn < 4) {
            bf16_t* dst = pn < 2 ? qa : kva; const int cbase = (pn & 1) * 256 + cl; float* sq = ssq + (pn < 2 ? 0 : 8) + (pn & 1) * 4 + wc;
            EPI_LOOP_ROWS { __builtin_amdgcn_sched_barrier(0); const int row = row0 + ai * 128 + m * 16; float ss = 0.f;
#pragma unroll
                for (int bj = 0; bj < 2; ++bj) { EPI_GET8(v);
#pragma unroll
                    for (int j = 0; j < 8; ++j) ss += v[j] * v[j];
                    __builtin_nontemporal_store(pack8(v), (u32x4*)(dst + (size_t)row * 512 + cbase + bj * 128)); }
                ss += __shfl_xor(ss, 16); ss += __shfl_xor(ss, 32);
                if (fq == 0) sq[(size_t)row * 16] = ss; }
        } else if (pn == 4) {
            EPI_LOOP_ROWS { __builtin_amdgcn_sched_barrier(0); const int row = row0 + ai * 128 + m * 16;
#pragma unroll
                for (int bj = 0; bj < 2; ++bj) { EPI_GET8(v); const int mc = bj * 128 + cl;
                    if (mc < 64) { rope8(v, cs, row & (SEQ - 1), mc >> 1); __builtin_nontemporal_store(pack8(v), (u32x4*)(krope + (size_t)row * 64 + mc)); }
                    else __builtin_nontemporal_store(pack8(v), (u32x4*)(misc + (size_t)row * 512 + mc)); } }
        } else {
            bf16_t* dst; int ld, act;
            if (pn == 5) { dst = misc + 256; ld = 512; act = 0; }
            else if (pn < 18) { dst = rkv + (pn - 6) * 256; ld = 3072; act = 0; }
            else if (pn < 26) { dst = z + (pn - 18) * 256; ld = 2048; act = 1; }
            else { dst = g + (pn - 26) * 256; ld = 4096; act = 2; }
            dst += cl;
            EPI_LOOP_ROWS { __builtin_amdgcn_sched_barrier(0); const int row = row0 + ai * 128 + m * 16;
#pragma unroll
                for (int bj = 0; bj < 2; ++bj) { EPI_GET8(v);
                    if (act) {
#pragma unroll
                        for (int j = 0; j < 8; ++j) { const float sg = sigmoidf_(v[j]); v[j] = act == 1 ? v[j] * sg : sg; } }
                    __builtin_nontemporal_store(pack8(v), (u32x4*)(dst + (size_t)row * ld + bj * 128)); } }
        }
    }
};
__device__ __forceinline__ float rstd_from_ssq(const float* sq) { const f32x4 a = *(const f32x4*)sq, b = *(const f32x4*)(sq + 4); const float s = ((a[0] + a[1]) + (a[2] + a[3])) + ((b[0] + b[1]) + (b[2] + b[3])); return rsqrtf(s * (1.f / 512.f) + 1e-6f); }
struct EpiQ {
    static constexpr bool PERM = true, MID = false;
    bf16_t* q; const float* ssq; const float* cs;
    __device__ __forceinline__ void operator()(AccRef acc, const Unit& u, int wr, int wc, int fr, int fq) const {
        const int row0 = u.pm * 256 + wr * 64 + fr, cl = u.pn * 256 + wc * 32 + 8 * fq;
        float rsv[2][4];
        EPI_LOOP_ROWS rsv[ai][m] = rstd_from_ssq(ssq + (size_t)(row0 + ai * 128 + m * 16) * 16);
        EPI_LOOP_ROWS { __builtin_amdgcn_sched_barrier(0); const int row = row0 + ai * 128 + m * 16; const float rs = rsv[ai][m];
#pragma unroll
            for (int bj = 0; bj < 2; ++bj) { EPI_GET8(v); const int gc = cl + bj * 128, hc = gc % 192;
#pragma unroll
                for (int j = 0; j < 8; ++j) v[j] *= rs;
                if (hc >= 128) rope8(v, cs, row & (SEQ - 1), (hc - 128) >> 1);
                *(u32x4*)(q + (size_t)row * 1536 + gc) = pack8(v); } }
    }
};
struct EpiKV {
    static constexpr bool PERM = true, MID = false;
    bf16_t* kv; const float* ssq;
    __device__ __forceinline__ void operator()(AccRef acc, const Unit& u, int wr, int wc, int fr, int fq) const {
        const int row0 = u.pm * 256 + wr * 64 + fr, cl = u.pn * 256 + wc * 32 + 8 * fq;
        float rsv[2][4];
        EPI_LOOP_ROWS rsv[ai][m] = rstd_from_ssq(ssq + (size_t)(row0 + ai * 128 + m * 16) * 16 + 8);
        EPI_LOOP_ROWS { __builtin_amdgcn_sched_barrier(0); const int row = row0 + ai * 128 + m * 16; const float rs = rsv[ai][m];
#pragma unroll
            for (int bj = 0; bj < 2; ++bj) { EPI_GET8(v);
#pragma unroll
                for (int j = 0; j < 8; ++j) v[j] *= rs;
                *(u32x4*)(kv + (size_t)row * 2048 + cl + bj * 128) = pack8(v); } }
    }
};
struct EpiLora {
    static constexpr bool PERM = true, MID = false;
    unsigned short* ua; int off; const float *bias_f, *bias_b;
    __device__ __forceinline__ void operator()(AccRef acc, const Unit& u, int wr, int wc, int fr, int fq) const {
        const int row0 = u.pm * 256 + wr * 64 + fr, cl = u.pn * 256 + wc * 32 + 8 * fq; const float* bias = u.pn < 4 ? bias_f : bias_b - 1024;
#pragma unroll
        for (int bj = 0; bj < 2; ++bj) { const int gc = cl + bj * 128; const f32x4 b0 = *(const f32x4*)(bias + gc), b1 = *(const f32x4*)(bias + gc + 4);
            EPI_LOOP_ROWS { __builtin_amdgcn_sched_barrier(0); const int row = row0 + ai * 128 + m * 16; EPI_GET8(v);
                u32x4 w; w.x = pk_f16(sigmoidf_(v[0] + b0[0]), sigmoidf_(v[1] + b0[1])); w.y = pk_f16(sigmoidf_(v[2] + b0[2]), sigmoidf_(v[3] + b0[3]));
                w.z = pk_f16(sigmoidf_(v[4] + b1[0]), sigmoidf_(v[5] + b1[1])); w.w = pk_f16(sigmoidf_(v[6] + b1[2]), sigmoidf_(v[7] + b1[3]));
                *(u32x4*)(ua + (size_t)row * 4096 + off + gc) = w; } }
    }
};
struct EpiMerge {
    static constexpr bool PERM = true, MID = true;
    const bf16_t* g; bf16_t* merged;
    __device__ __forceinline__ void mid(f32x4 (&acc)[2][2][4][2], const Unit& u, int wr, int wc, int fr, int fq) const {
        int row0 = u.pm * 256 + wr * 64 + fr, cl = u.pn * 256 + wc * 32 + 8 * fq; asm volatile("" : "+v"(row0), "+v"(cl));
#pragma unroll
        for (int ai = 0; ai < 2; ++ai) { u32x4 w1[4][2], w2[4][2];
            __builtin_amdgcn_sched_barrier(0);
#pragma unroll
            for (int m = 0; m < 4; ++m)
#pragma unroll
                for (int bj = 0; bj < 2; ++bj) { const bf16_t* gp = g + (size_t)(row0 + ai * 128 + m * 16) * 4096 + cl + bj * 128; w1[m][bj] = *(const u32x4*)gp; w2[m][bj] = *(const u32x4*)(gp + 2048); }
            __builtin_amdgcn_sched_barrier(0);
#pragma unroll
            for (int m = 0; m < 4; ++m)
#pragma unroll
                for (int bj = 0; bj < 2; ++bj) { float g1[8], g2[8]; unpack8(w1[m][bj], g1); unpack8(w2[m][bj], g2);
#pragma unroll
                    for (int j = 0; j < 4; ++j) { acc[ai][bj][m][0][j] *= g1[j] * __builtin_amdgcn_rcpf(fmaxf(g2[j], 1e-30f)); acc[ai][bj][m][1][j] *= g1[4 + j] * __builtin_amdgcn_rcpf(fmaxf(g2[4 + j], 1e-30f)); } } }
    }
    __device__ __forceinline__ void operator()(AccRef acc, const Unit& u, int wr, int wc, int fr, int fq) const {
        const int row0 = u.pm * 256 + wr * 64 + fr, cl = u.pn * 256 + wc * 32 + 8 * fq;
#pragma unroll
        for (int ai = 0; ai < 2; ++ai) { u32x4 w2[4][2];
            __builtin_amdgcn_sched_barrier(0);
#pragma unroll
            for (int m = 0; m < 4; ++m)
#pragma unroll
                for (int bj = 0; bj < 2; ++bj) w2[m][bj] = *(const u32x4*)(g + (size_t)(row0 + ai * 128 + m * 16) * 4096 + 2048 + cl + bj * 128);
            __builtin_amdgcn_sched_barrier(0);
#pragma unroll
            for (int m = 0; m < 4; ++m) { const int row = row0 + ai * 128 + m * 16;
#pragma unroll
                for (int bj = 0; bj < 2; ++bj) { EPI_GET8(v); const int gc = cl + bj * 128; float g2[8]; unpack8(w2[m][bj], g2);
#pragma unroll
                    for (int j = 0; j < 8; ++j) v[j] *= g2[j];
                    *(u32x4*)(merged + (size_t)row * 2048 + gc) = pack8(v); } } }
    }
};
struct EpiOut {
    static constexpr bool PERM = true, MID = false;
    bf16_t* o;
    __device__ __forceinline__ void operator()(AccRef acc, const Unit& u, int wr, int wc, int fr, int fq) const {
        const int row0 = u.pm * 256 + wr * 64 + fr, cl = u.pn * 256 + wc * 32 + 8 * fq;
        EPI_LOOP_ROWS { __builtin_amdgcn_sched_barrier(0); const int row = row0 + ai * 128 + m * 16;
#pragma unroll
            for (int bj = 0; bj < 2; ++bj) { EPI_GET8(v); *(u32x4*)(o + (size_t)row * 2048 + cl + bj * 128) = pack8(v); } }
    }
};

namespace att {
constexpr int NW = 8, QBLK = 32, KVBLK = 64;
constexpr float SCALE = 0.07216878364870322f;
constexpr float THR = 8.f;
constexpr int LDQ = 1536, LDK = 2048, LDR = 64, LDO = 2048;
constexpr size_t SHM_V = KVBLK * 128 * 2, SHM_K = KVBLK * 128 * 2, SHM_R = KVBLK * 64 * 2;
#define KSWZ(row, colB) ((row) * 256 + ((colB) ^ (((row) & 7) << 4)))
#define RSWZ(row, colB) ((row) * 128 + ((colB) ^ ((((row) >> 1) & 7) << 4)))
#define SBAR() __builtin_amdgcn_sched_barrier(0)
__device__ __forceinline__ int crow(int r, int hi) { return (r & 3) + 8 * (r >> 2) + 4 * hi; }
__device__ __forceinline__ void partialSM(f32x16& p0, f32x16& p1, float& m_reg, float& mn, float& alpha) {
    constexpr float C = SCALE * 1.4426950408889634f;
    float pmax = p0[0];
#pragma unroll
    for (int r = 1; r < 16; ++r) pmax = fmaxf(pmax, p0[r]);
#pragma unroll
    for (int r = 0; r < 16; ++r) pmax = fmaxf(pmax, p1[r]);
    { auto rr = __builtin_amdgcn_permlane32_swap(__float_as_uint(pmax), __float_as_uint(pmax), false, false); pmax = fmaxf(__uint_as_float(rr[0]), __uint_as_float(rr[1])); }
    if (__builtin_expect(__all(pmax - m_reg <= THR / SCALE), 1)) { mn = m_reg; alpha = 1.f; }
    else { mn = fmaxf(m_reg, pmax); alpha = __builtin_amdgcn_exp2f((m_reg - mn) * C); m_reg = mn; }
    const float mnC = -mn * C;
#pragma unroll
    for (int r = 0; r < 16; ++r) p0[r] = fmaf(p0[r], C, mnC);
#pragma unroll
    for (int r = 0; r < 16; ++r) p1[r] = fmaf(p1[r], C, mnC);
#pragma unroll
    for (int r = 0; r < 16; ++r) p0[r] = __builtin_amdgcn_exp2f(p0[r]);
}
__device__ __forceinline__ void finishSM(f32x16& p0, f32x16& p1, float alpha, float& l_reg, bf16x8& pa0, bf16x8& pa1, bf16x8& pa2, bf16x8& pa3) {
#pragma unroll
    for (int r = 0; r < 16; ++r) p1[r] = __builtin_amdgcn_exp2f(p1[r]);
    float ps = 0;
#pragma unroll
    for (int r = 0; r < 16; ++r) ps += p0[r];
#pragma unroll
    for (int r = 0; r < 16; ++r) ps += p1[r];
    { auto rr = __builtin_amdgcn_permlane32_swap(__float_as_uint(ps), __float_as_uint(ps), false, false); ps = __uint_as_float(rr[0]) + __uint_as_float(rr[1]); }
    l_reg = l_reg * alpha + ps;
#define PK4(P, BASE, OUT) do { unsigned a0 = cvt_pk_bf16(P[BASE + 0], P[BASE + 1]), a1 = cvt_pk_bf16(P[BASE + 2], P[BASE + 3]);   \
    unsigned b0 = cvt_pk_bf16(P[BASE + 4], P[BASE + 5]), b1 = cvt_pk_bf16(P[BASE + 6], P[BASE + 7]);                              \
    auto r0 = __builtin_amdgcn_permlane32_swap(a0, b0, false, false); auto r1 = __builtin_amdgcn_permlane32_swap(a1, b1, false, false); \
    u32x4 w = {r0[0], r1[0], r0[1], r1[1]}; OUT = *reinterpret_cast<bf16x8*>(&w); } while (0)
    PK4(p0, 0, pa0); PK4(p0, 8, pa1); PK4(p1, 0, pa2); PK4(p1, 8, pa3);
#undef PK4
}
__device__ __forceinline__ void qkt(f32x16& p0, f32x16& p1, const char* Ks, const char* Rs, const bf16x8* qr, const char* qrl, int r32, int hi) {
    p0 = f32x16{}; p1 = f32x16{};
#pragma unroll
    for (int d0 = 0; d0 < 8; ++d0) { const int cb = (d0 * 16 + hi * 8) * 2;
        const bf16x8 b0 = *reinterpret_cast<const bf16x8*>(Ks + KSWZ(r32, cb));
        const bf16x8 b1 = *reinterpret_cast<const bf16x8*>(Ks + KSWZ(32 + r32, cb));
        const bf16x8 qv = d0 < 6 ? qr[d0] : *reinterpret_cast<const bf16x8*>(qrl + (d0 - 6) * 1024);
        p0 = __builtin_amdgcn_mfma_f32_32x32x16_bf16(b0, qv, p0, 0, 0, 0);
        p1 = __builtin_amdgcn_mfma_f32_32x32x16_bf16(b1, qv, p1, 0, 0, 0); }
#pragma unroll
    for (int d0 = 0; d0 < 4; ++d0) { const int cb = (d0 * 16 + hi * 8) * 2;
        const bf16x8 b0 = *reinterpret_cast<const bf16x8*>(Rs + RSWZ(r32, cb));
        const bf16x8 b1 = *reinterpret_cast<const bf16x8*>(Rs + RSWZ(32 + r32, cb));
        const bf16x8 qv = *reinterpret_cast<const bf16x8*>(qrl + (2 + d0) * 1024);
        p0 = __builtin_amdgcn_mfma_f32_32x32x16_bf16(b0, qv, p0, 0, 0, 0);
        p1 = __builtin_amdgcn_mfma_f32_32x32x16_bf16(b1, qv, p1, 0, 0, 0); }
}
__device__ __forceinline__ int v_st(int k, int c) { const int kk = (k & ~0xC) | ((k & 4) << 1) | ((k & 8) >> 1); return ((kk >> 3) * 4 + (c >> 5)) * 512 + ((kk & 7) * 32 + (c & 31)) * 2; }
__device__ __forceinline__ int v_rd_base(int lane) { return ((lane & 3) << 3) | (((lane >> 2) & 3) << 6) | (((lane >> 4) & 1) << 5) | (((lane >> 5) & 1) << 8); }
constexpr int v_rd_off(int d0, int ks, int half) { return d0 * 512 + ks * 4096 + half * 2048; }
template <int OFF> __device__ __forceinline__ s16x4 tr_read(int vb) { s16x4 r; asm volatile("ds_read_b64_tr_b16 %0, %1 offset:%2" : "=&v"(r) : "v"(vb), "i"(OFF) : "memory"); return r; }
template <int D0> __device__ __forceinline__ void pv_one(f32x16& od, int vb, bf16x8 pa0, bf16x8 pa1, bf16x8 pa2, bf16x8 pa3) {
    const s16x4 l0 = tr_read<v_rd_off(D0, 0, 0)>(vb), h0 = tr_read<v_rd_off(D0, 0, 1)>(vb), l1 = tr_read<v_rd_off(D0, 1, 0)>(vb), h1 = tr_read<v_rd_off(D0, 1, 1)>(vb);
    const s16x4 l2 = tr_read<v_rd_off(D0, 2, 0)>(vb), h2 = tr_read<v_rd_off(D0, 2, 1)>(vb), l3 = tr_read<v_rd_off(D0, 3, 0)>(vb), h3 = tr_read<v_rd_off(D0, 3, 1)>(vb);
    asm volatile("s_waitcnt lgkmcnt(0)" ::: "memory"); SBAR();
#define PK(L, H) (bf16x8){L[0], L[1], L[2], L[3], H[0], H[1], H[2], H[3]}
    od = __builtin_amdgcn_mfma_f32_32x32x16_bf16(pa0, PK(l0, h0), od, 0, 0, 0);
    od = __builtin_amdgcn_mfma_f32_32x32x16_bf16(pa1, PK(l1, h1), od, 0, 0, 0);
    od = __builtin_amdgcn_mfma_f32_32x32x16_bf16(pa2, PK(l2, h2), od, 0, 0, 0);
    od = __builtin_amdgcn_mfma_f32_32x32x16_bf16(pa3, PK(l3, h3), od, 0, 0, 0);
#undef PK
}
__device__ __forceinline__ void pv_d0(f32x16* o, int vb, bf16x8 pa0, bf16x8 pa1, bf16x8 pa2, bf16x8 pa3) {
    pv_one<0>(o[0], vb, pa0, pa1, pa2, pa3); pv_one<1>(o[1], vb, pa0, pa1, pa2, pa3); pv_one<2>(o[2], vb, pa0, pa1, pa2, pa3); pv_one<3>(o[3], vb, pa0, pa1, pa2, pa3);
}
__device__ __forceinline__ void attn_body(const bf16_t* __restrict__ Qb, const bf16_t* __restrict__ Kh, const bf16_t* __restrict__ Vh, const bf16_t* __restrict__ Rh,
                                          bf16_t* __restrict__ Zb, int seq, char* lds, int tid_in) {
    int tid_l = tid_in; asm volatile("" : "+v"(tid_l));
    const int tid = tid_l, wid = tid >> 6, lane = tid & 63, r32 = lane & 31, hi = lane >> 5;
    char* V_lds = lds; char* K_lds = lds + 2 * SHM_V; char* R_lds = lds + 2 * SHM_V + 2 * SHM_K;
    float* wsf = (float*)(lds + 2 * SHM_V + 2 * SHM_K + 2 * SHM_R) + wid * 64; float* li_l = wsf; float* al_l = wsf + 32;
    float m_reg = -1e30f, l_reg = 0; f32x16 o[4] = {}; bf16x8 qr[6];
    char* qrl = lds + 2 * SHM_V + 2 * SHM_K + 2 * SHM_R + 2048 + wid * 6144 + lane * 16;
    const bf16_t* Qw = Qb + (long)(wid * QBLK + r32) * LDQ + hi * 8;
#pragma unroll
    for (int d0 = 0; d0 < 6; ++d0) qr[d0] = *reinterpret_cast<const bf16x8*>(Qw + d0 * 16);
    const int sr = tid >> 4, sc = (tid & 15) * 8, vst0 = v_st(sr, sc), vst1 = v_st(32 + sr, sc);
    const int rr_ = tid >> 3, rc_ = (tid & 7) * 8;
    const int vb0 = (int)(uintptr_t)V_lds + v_rd_base(lane);
    struct { bf16x8 vs0, vs1, ks0, ks1, rs; } sr_[1];
#define SLOAD(i, k0) do { sr_[i].vs0 = *(const bf16x8*)(&Vh[(long)((k0) + sr) * LDK + sc]); sr_[i].vs1 = *(const bf16x8*)(&Vh[(long)((k0) + 32 + sr) * LDK + sc]); \
    sr_[i].ks0 = *(const bf16x8*)(&Kh[(long)((k0) + sr) * LDK + sc]); sr_[i].ks1 = *(const bf16x8*)(&Kh[(long)((k0) + 32 + sr) * LDK + sc]); \
    sr_[i].rs = *(const bf16x8*)(&Rh[(long)((k0) + rr_) * LDR + rc_]); } while (0)
#define SWRITE(b, i) do { *(bf16x8*)(V_lds + (b) * SHM_V + vst0) = sr_[i].vs0; *(bf16x8*)(V_lds + (b) * SHM_V + vst1) = sr_[i].vs1; const int kc = sc * 2;  \
    *(bf16x8*)(K_lds + (b) * SHM_K + KSWZ(sr, kc)) = sr_[i].ks0; *(bf16x8*)(K_lds + (b) * SHM_K + KSWZ(32 + sr, kc)) = sr_[i].ks1; \
    *(bf16x8*)(R_lds + (b) * SHM_R + RSWZ(rr_, rc_ * 2)) = sr_[i].rs; } while (0)
#define SWAIT() asm volatile("s_waitcnt vmcnt(0)" ::: "memory")
#define RESC(a) do { if (__any((a) < 1.f)) { if (hi == 0) al_l[r32] = (a); asm volatile("s_waitcnt lgkmcnt(0)" ::: "memory"); \
    _Pragma("unroll") for (int d = 0; d < 4; ++d) _Pragma("unroll") for (int r = 0; r < 16; ++r) o[d][r] *= al_l[crow(r, hi)]; } } while (0)
    f32x16 pA0, pA1, pB0, pB1; float mnA, mnB, alA, alB; bf16x8 pa0, pa1, pa2, pa3; const int NT = seq / KVBLK;
    __syncthreads();
#pragma unroll
    for (int d0 = 0; d0 < 6; ++d0) *reinterpret_cast<bf16x8*>(qrl + d0 * 1024) = *reinterpret_cast<const bf16x8*>(Qw + 96 + d0 * 16);
    SLOAD(0, 0); asm volatile("s_waitcnt vmcnt(0)" ::: "memory"); SWRITE(0, 0); __syncthreads();
    qkt(pA0, pA1, K_lds, R_lds, qr, qrl, r32, hi); partialSM(pA0, pA1, m_reg, mnA, alA);
    SLOAD(0, KVBLK);
    SWAIT(); SWRITE(1, 0); __syncthreads();
    for (int j = 1; j + 1 < NT; j += 2) {
        SBAR(); qkt(pB0, pB1, K_lds + SHM_K, R_lds + SHM_R, qr, qrl, r32, hi);
        finishSM(pA0, pA1, alA, l_reg, pa0, pa1, pa2, pa3); SBAR();
        SLOAD(0, (j + 1) * KVBLK); SBAR();
        pv_d0(o, vb0, pa0, pa1, pa2, pa3); partialSM(pB0, pB1, m_reg, mnB, alB);
        __syncthreads(); SWAIT(); SWRITE(0, 0);
        RESC(alB); __syncthreads();
        SBAR(); qkt(pA0, pA1, K_lds, R_lds, qr, qrl, r32, hi);
        finishSM(pB0, pB1, alB, l_reg, pa0, pa1, pa2, pa3); SBAR();
        SLOAD(0, (j + 2) * KVBLK); SBAR();
        pv_d0(o, vb0 + (int)SHM_V, pa0, pa1, pa2, pa3); partialSM(pA0, pA1, m_reg, mnA, alA);
        __syncthreads(); SWAIT(); SWRITE(1, 0);
        RESC(alA); __syncthreads();
    }
    SBAR(); qkt(pB0, pB1, K_lds + SHM_K, R_lds + SHM_R, qr, qrl, r32, hi);
    finishSM(pA0, pA1, alA, l_reg, pa0, pa1, pa2, pa3); SBAR();
    pv_d0(o, vb0, pa0, pa1, pa2, pa3); partialSM(pB0, pB1, m_reg, mnB, alB);
    __syncthreads(); RESC(alB);
    finishSM(pB0, pB1, alB, l_reg, pa0, pa1, pa2, pa3); SBAR();
    pv_d0(o, vb0 + (int)SHM_V, pa0, pa1, pa2, pa3);
    if (hi == 0) li_l[r32] = l_reg;
    __syncthreads();
    { constexpr int SP = 272;
      char* stg = lds + wid * (32 * SP);
#pragma unroll
      for (int r = 0; r < 16; ++r) { const int orow = crow(r, hi); const float rli = __builtin_amdgcn_rcpf(li_l[orow]);
#pragma unroll
          for (int d0 = 0; d0 < 4; ++d0) *(bf16_t*)(stg + orow * SP + (d0 * 32 + r32) * 2) = f2bf(o[d0][r] * rli); }
      asm volatile("s_waitcnt lgkmcnt(0)" ::: "memory");
      bf16_t* Zw = Zb + (long)(wid * QBLK) * LDO;
      u32x4 zw[8];
#pragma unroll
      for (int i = 0; i < 8; ++i) { const int c = i * 64 + lane; zw[i] = *(const u32x4*)(Zw + (long)(c >> 4) * LDO + (c & 15) * 8); }
#pragma unroll
      for (int i = 0; i < 8; ++i) { const int c = i * 64 + lane, row = c >> 4, col8 = (c & 15) * 8;
          float ov[8], zv[8]; unpack8(*(const u32x4*)(stg + row * SP + col8 * 2), ov); unpack8(zw[i], zv);
#pragma unroll
          for (int e = 0; e < 8; ++e) ov[e] *= zv[e];
          *(u32x4*)(Zw + (long)row * LDO + col8) = pack8(ov); } }
#undef SLOAD
#undef SWRITE
#undef SWAIT
#undef RESC
}
}

__device__ __forceinline__ int map_col(int mode, int n) {
    if (mode == 1) {
        if (n < 1024) return n;
        if (n < 1536) { const int m = n - 1024; if (m < 64) return 1024 + (m >> 1) + 32 * (m & 1); if (m < 448) return 4096 + m; return -1; }
        if (n < 4608) return 1088 + (n - 1536);
        return n - 64;
    }
    if (mode == 2) { const int h = n / 192, c = n % 192; if (c < 128) return n; const int m = c - 128; return h * 192 + 128 + (m >> 1) + 32 * (m & 1); }
    return n;
}
__device__ __forceinline__ void transpose_tile(const float* src, int lds_, int K, bf16_t* dst, int mode, const float* scale, int tile, float* tl, int tid, int ldd = 0) {
    if (ldd == 0) ldd = K;
    const int nkb = K / 64, nb = tile / nkb, kb = tile % nkb, n0 = nb * 64, k0 = kb * 64;
    const int s0 = map_col(mode, n0), s63 = map_col(mode, n0 + 63);
    __syncthreads();
    if ((s0 >= 0 && s63 == s0 + 63 && map_col(mode, n0 + 1) == s0 + 1) || (s0 < 0 && s63 < 0)) {
        const int n4 = (tid & 15) * 4;
#pragma unroll
        for (int it = 0; it < 2; ++it) { const int kk = (tid >> 4) + 32 * it; f32x4 v = s0 >= 0 ? *(const f32x4*)(src + (size_t)(k0 + kk) * lds_ + s0 + n4) : (f32x4){0.f, 0.f, 0.f, 0.f};
            if (scale) v = v * scale[k0 + kk];
            tl[kk * 65 + n4 + 0] = v[0]; tl[kk * 65 + n4 + 1] = v[1]; tl[kk * 65 + n4 + 2] = v[2]; tl[kk * 65 + n4 + 3] = v[3]; }
    } else {
        const int nn = tid & 63, sc = map_col(mode, n0 + nn);
#pragma unroll
        for (int it = 0; it < 8; ++it) { const int kk = (tid >> 6) + 8 * it; float v = sc >= 0 ? src[(size_t)(k0 + kk) * lds_ + sc] : 0.f; if (scale) v *= scale[k0 + kk]; tl[kk * 65 + nn] = v; }
    }
    __syncthreads();
    const int nr = tid >> 3, kc = (tid & 7) * 8; float v[8];
#pragma unroll
    for (int e = 0; e < 8; ++e) v[e] = tl[(kc + e) * 65 + nr];
    *(u32x4*)(dst + (size_t)(n0 + nr) * ldd + k0 + kc) = pack8(v);
}

constexpr int SC_C = 32;
struct ScanOps { f32x4 w0, w1, a0, a1, b0, b1, k0, k1, r0, r1; float v; };
__device__ __forceinline__ void scan_chain(const Params& p, int c, char* lds, int tid_in) {
    const bf16_t* rkv = (const bf16_t*)(p.ws + WS_RKV); const unsigned short* ua = (const unsigned short*)(p.ws + WS_UA);
    const int dir = c >> 7, b = (c >> 4) & 7, h = c & 15;
    float* yout = (float*)(p.ws + (dir ? WS_YB : WS_YF));
    int tid_l = tid_in; asm volatile("" : "+v"(tid_l));
    const int tid = tid_l, wid = tid >> 6, lane = tid & 63, row = tid >> 3, sub = tid & 7;
    float* L = (float*)lds;
    float* ybuf = L + 2 * 6 * SC_C * 64;
    const int psl = tid >> 4, pc4 = (tid & 15) * 4, ch = h * 64 + pc4;
    const f32x4 mu_r = *(const f32x4*)(p.mu + ch), mu_k = *(const f32x4*)(p.mu + 1024 + ch), mu_v = *(const f32x4*)(p.mu + 2048 + ch), kk_c = *(const f32x4*)(p.k_k + ch), ka_c = *(const f32x4*)(p.k_a + ch);
    f32x2 s01 = {0.f, 0.f}, s23 = {0.f, 0.f}, s45 = {0.f, 0.f}, s67 = {0.f, 0.f};
    u32x2 raw[3][3], raw_u, raw_a;
    const size_t tok0 = (size_t)b * SEQ;
#define SC_LOAD(chunk) do { const int st = (chunk) * SC_C + psl; const int t = dir ? (SEQ - 1 - st) : st; \
        const bf16_t* base = rkv + (tok0 + t) * 3072 + ch; const bool hm = t > 0, hp = t < SEQ - 1; \
        _Pragma("unroll") for (int sg = 0; sg < 3; ++sg) { raw[sg][1] = *(const u32x2*)(base + sg * 1024); \
            raw[sg][0] = hm ? *(const u32x2*)(base + sg * 1024 - 3072) : (u32x2){0u, 0u}; raw[sg][2] = hp ? *(const u32x2*)(base + sg * 1024 + 3072) : (u32x2){0u, 0u}; } \
        const unsigned short* ub = ua + (tok0 + t) * 4096 + dir * 1024 + ch; raw_u = *(const u32x2*)ub; raw_a = *(const u32x2*)(ub + 2048); } while (0)
#define SC_PREP(bufi) do { float* Lb = L + (bufi) * 6 * SC_C * 64 + psl * 64 + pc4; float rr[3][3][4]; \
        _Pragma("unroll") for (int sg = 0; sg < 3; ++sg) _Pragma("unroll") for (int d = 0; d < 3; ++d) unpack4(raw[sg][d], rr[sg][d]); \
        float uu[4], aa[4]; unpack4h(raw_u, uu); unpack4h(raw_a, aa); f32x4 r4, k4, v4, kk4; float n2 = 0.f; \
        _Pragma("unroll") for (int e = 0; e < 4; ++e) { r4[e] = rr[0][1][e] + mu_r[e] * (0.5f * (rr[0][0][e] + rr[0][2][e]) - rr[0][1][e]); k4[e] = rr[1][1][e] + mu_k[e] * (0.5f * (rr[1][0][e] + rr[1][2][e]) - rr[1][1][e]); \
            v4[e] = rr[2][1][e] + mu_v[e] * (0.5f * (rr[2][0][e] + rr[2][2][e]) - rr[2][1][e]); kk4[e] = k4[e] * kk_c[e]; n2 += kk4[e] * kk4[e]; } \
        const float rn = __builtin_amdgcn_rsqf(fmaxf(red16(n2), 1e-24f)); f32x4 w4, na4, b4, kf4; \
        _Pragma("unroll") for (int e = 0; e < 4; ++e) { const float kk = kk4[e] * rn; w4[e] = __expf(-0.6065306597126334f * uu[e]); na4[e] = -kk; b4[e] = kk * aa[e]; kf4[e] = k4[e] * (1.f + (aa[e] - 1.f) * ka_c[e]); } \
        *(f32x4*)(Lb + 0 * SC_C * 64) = w4; *(f32x4*)(Lb + 1 * SC_C * 64) = na4; *(f32x4*)(Lb + 2 * SC_C * 64) = b4; *(f32x4*)(Lb + 3 * SC_C * 64) = kf4; *(f32x4*)(Lb + 4 * SC_C * 64) = r4; *(f32x4*)(Lb + 5 * SC_C * 64) = v4; } while (0)
#define SC_FLUSH(chunk) do { const float* yb = ybuf + ((chunk) & 1) * SC_C * 64; const int sl = tid >> 4, i4 = (tid & 15) * 4; const int st = (chunk) * SC_C + sl; const int t = dir ? (SEQ - 1 - st) : st; \
        *(f32x4*)(yout + (tok0 + t) * 1024 + h * 64 + i4) = *(const f32x4*)(yb + sl * 64 + i4); } while (0)
    constexpr int NCH = SEQ / SC_C;
    __syncthreads();
    SC_LOAD(0); SC_PREP(0); __syncthreads();
    for (int n = 0; n < NCH; ++n) {
        if (n + 1 < NCH) SC_LOAD(n + 1);
        if (n > 0) SC_FLUSH(n - 1);
        const float* Lb = L + (n & 1) * 6 * SC_C * 64 + sub * 8; float* yb = ybuf + (n & 1) * SC_C * 64;
        const float* Lv = L + (n & 1) * 6 * SC_C * 64 + 5 * SC_C * 64 + row;
#define SC_LDA(O, sl) do { O.w0 = *(const f32x4*)(Lb + (0 * SC_C + (sl)) * 64); O.w1 = *(const f32x4*)(Lb + (0 * SC_C + (sl)) * 64 + 4); O.a0 = *(const f32x4*)(Lb + (1 * SC_C + (sl)) * 64); O.a1 = *(const f32x4*)(Lb + (1 * SC_C + (sl)) * 64 + 4); \
        O.b0 = *(const f32x4*)(Lb + (2 * SC_C + (sl)) * 64); O.b1 = *(const f32x4*)(Lb + (2 * SC_C + (sl)) * 64 + 4); } while (0)
#define SC_LDB(O, sl) do { O.k0 = *(const f32x4*)(Lb + (3 * SC_C + (sl)) * 64); O.k1 = *(const f32x4*)(Lb + (3 * SC_C + (sl)) * 64 + 4); \
        O.r0 = *(const f32x4*)(Lb + (4 * SC_C + (sl)) * 64); O.r1 = *(const f32x4*)(Lb + (4 * SC_C + (sl)) * 64 + 4); O.v = Lv[(sl) * 64]; } while (0)
#define SC_LD(O, sl) do { SC_LDA(O, sl); SC_LDB(O, sl); } while (0)
#define LO2(x) __builtin_shufflevector(x, x, 0, 1)
#define HI2(x) __builtin_shufflevector(x, x, 2, 3)
        ScanOps o0, o1, o2; SC_LD(o0, 0); SC_LD(o1, 1);
        float ysel = 0.f, ypend = 0.f;
#define SC_STEP(cur, ld, u) do { \
            f32x2 acc = s01 * LO2(cur.a0); acc = __builtin_elementwise_fma(s23, HI2(cur.a0), acc); acc = __builtin_elementwise_fma(s45, LO2(cur.a1), acc); acc = __builtin_elementwise_fma(s67, HI2(cur.a1), acc); \
            float t_ = acc.x + acc.y; \
            t_ += dppx<0xB1>(t_); ypend += dppx<0xB1>(ypend); t_ += dppx<0x4E>(t_); ypend += dppx<0x4E>(ypend); t_ += dppx<0x141>(t_); ypend += dppx<0x141>(ypend); \
            const float sa = t_; \
            if ((u) > 0) { ysel = (sub == (((u) - 1) & 7)) ? ypend : ysel; if ((((u) - 1) & 7) == 7) yb[((u) - 8 + sub) * 64 + row] = ysel; } \
            __builtin_amdgcn_sched_barrier(0); if ((u) + 2 < SC_C) SC_LDA(ld, (u) + 2); __builtin_amdgcn_sched_barrier(0); \
            const f32x2 sa2 = {sa, sa}, vi2 = {cur.v, cur.v}; \
            s01 = __builtin_elementwise_fma(LO2(cur.k0), vi2, __builtin_elementwise_fma(LO2(cur.b0), sa2, s01 * LO2(cur.w0))); \
            s23 = __builtin_elementwise_fma(HI2(cur.k0), vi2, __builtin_elementwise_fma(HI2(cur.b0), sa2, s23 * HI2(cur.w0))); \
            s45 = __builtin_elementwise_fma(LO2(cur.k1), vi2, __builtin_elementwise_fma(LO2(cur.b1), sa2, s45 * LO2(cur.w1))); \
            s67 = __builtin_elementwise_fma(HI2(cur.k1), vi2, __builtin_elementwise_fma(HI2(cur.b1), sa2, s67 * HI2(cur.w1))); \
            __builtin_amdgcn_sched_barrier(0); if ((u) + 2 < SC_C) SC_LDB(ld, (u) + 2); __builtin_amdgcn_sched_barrier(0); \
            f32x2 yy = s01 * LO2(cur.r0); yy = __builtin_elementwise_fma(s23, HI2(cur.r0), yy); yy = __builtin_elementwise_fma(s45, LO2(cur.r1), yy); yy = __builtin_elementwise_fma(s67, HI2(cur.r1), yy); \
            ypend = yy.x + yy.y;     \
            __builtin_amdgcn_sched_barrier(0); } while (0)
#define SC_STEP3(u) SC_STEP(o0, o2, u); SC_STEP(o1, o0, (u) + 1); SC_STEP(o2, o1, (u) + 2)
        SC_STEP3(0); SC_STEP3(3); SC_STEP3(6); SC_STEP3(9); SC_STEP3(12); SC_STEP3(15); SC_STEP3(18); SC_STEP3(21); SC_STEP3(24); SC_STEP3(27);
        SC_STEP(o0, o2, 30); SC_STEP(o1, o0, 31);
        { const float yl = red8(ypend); ysel = (sub == 7) ? yl : ysel; yb[(24 + sub) * 64 + row] = ysel; }
#undef SC_STEP3
#undef SC_STEP
#undef SC_LD
#undef SC_LDA
#undef SC_LDB
#undef LO2
#undef HI2
        if (n + 1 < NCH) SC_PREP((n + 1) & 1);
        __syncthreads();
    }
    SC_FLUSH(NCH - 1);
#undef SC_LOAD
#undef SC_PREP
#undef SC_FLUSH
}

struct P5In { f32x4 yf, yb; u32x2 r[3][3]; u32x2 af, ab, z; };
__device__ __forceinline__ void p5_load(P5In& in, int it, int c4, const float* __restrict__ yf, const float* __restrict__ yb, const bf16_t* __restrict__ rkv, const unsigned short* __restrict__ ua, const bf16_t* zb) {
    const int row = it >> 2, ch = (it & 3) * 256 + c4, t = row & (SEQ - 1);
    in.yf = *(const f32x4*)(yf + (size_t)row * 1024 + ch); in.yb = *(const f32x4*)(yb + (size_t)row * 1024 + ch);
    const bf16_t* base = rkv + (size_t)row * 3072 + ch; const bool hm = t > 0, hp = t < SEQ - 1;
#pragma unroll
    for (int sg = 0; sg < 3; ++sg) { in.r[sg][1] = *(const u32x2*)(base + sg * 1024);
        in.r[sg][0] = hm ? *(const u32x2*)(base + sg * 1024 - 3072) : (u32x2){0u, 0u}; in.r[sg][2] = hp ? *(const u32x2*)(base + sg * 1024 + 3072) : (u32x2){0u, 0u}; }
    const unsigned short* ub = ua + (size_t)row * 4096 + 2048 + ch; in.af = *(const u32x2*)ub; in.ab = *(const u32x2*)(ub + 1024);
    in.z = *(const u32x2*)(zb + (size_t)row * 2048 + 1024 + ch);
}
struct P5Par { f32x4 mur, muk, muv, ka, rk, gg, gb; };
__device__ __forceinline__ void p5_finish(const P5In& in, int it, int c4, const P5Par& pp, bf16_t* zb) {
    const int row = it >> 2, ch = (it & 3) * 256 + c4;
    const f32x4 mur = pp.mur, muk = pp.muk, muv = pp.muv, ka = pp.ka, rk = pp.rk, gg = pp.gg, gb = pp.gb;
    float y[4], sy = 0.f;
#pragma unroll
    for (int e = 0; e < 4; ++e) { y[e] = in.yf[e] + in.yb[e]; sy += y[e]; }
    const float mean = red16(sy) * (1.f / 64.f); float sv = 0.f;
#pragma unroll
    for (int e = 0; e < 4; ++e) { y[e] -= mean; sv += y[e] * y[e]; }
    const float rstd = rsqrtf(red16(sv) * (1.f / 64.f) + 64e-5f);
    float rr[3][3][4];
#pragma unroll
    for (int sg = 0; sg < 3; ++sg)
#pragma unroll
        for (int d = 0; d < 3; ++d) unpack4(in.r[sg][d], rr[sg][d]);
    float af[4], ab[4], zz[4], vv[4], sb = 0.f; unpack4h(in.af, af); unpack4h(in.ab, ab); unpack4(in.z, zz);
#pragma unroll
    for (int e = 0; e < 4; ++e) { const float r = rr[0][1][e] + mur[e] * (0.5f * (rr[0][0][e] + rr[0][2][e]) - rr[0][1][e]), k = rr[1][1][e] + muk[e] * (0.5f * (rr[1][0][e] + rr[1][2][e]) - rr[1][1][e]);
        vv[e] = rr[2][1][e] + muv[e] * (0.5f * (rr[2][0][e] + rr[2][2][e]) - rr[2][1][e]);
        sb += r * (k * (2.f + (af[e] + ab[e] - 2.f) * ka[e])) * rk[e]; }
    const float bon = red16(sb);
    float o[4];
#pragma unroll
    for (int e = 0; e < 4; ++e) o[e] = (y[e] * rstd * gg[e] + gb[e] + bon * vv[e]) * zz[e];
    u32x2 w; w.x = cvt_pk_bf16(o[0], o[1]); w.y = cvt_pk_bf16(o[2], o[3]);
    *(u32x2*)(zb + (size_t)row * 2048 + 1024 + ch) = w;
}

constexpr int T_IN = (NP1 / 64) * 32, T_Q = 24 * 8, T_KV = 32 * 8, T_BM = 32 * 16, T_OUT = 32 * 32, T_REST = T_Q + T_KV + 2 * T_BM + T_OUT;
constexpr int LDS_PHASE_BYTES = 139264;
#define XB_TMO      128
#define XB_XCNT(j)  (256  + 64 * (j))
#define XB_XSUB(j)  (1280 + 64 * (j))
#define XB_XGEN(j)  (2304 + 64 * (j))
#define XB_TOP      3328
#define XB_TOPGEN   3392
#define XCD_BAR_WORDS 3456
#define XB_SPIN_CAP (1u << 20)
__device__ __forceinline__ unsigned xb_ld(unsigned* p)              { return __hip_atomic_load(p, __ATOMIC_RELAXED, __HIP_MEMORY_SCOPE_AGENT); }
__device__ __forceinline__ unsigned xb_add(unsigned* p, unsigned v) { return __hip_atomic_fetch_add(p, v, __ATOMIC_RELAXED, __HIP_MEMORY_SCOPE_AGENT); }
__device__ __forceinline__ unsigned xb_xcc_id() { return (unsigned)__builtin_amdgcn_s_getreg((3 << 11) | 20) & 0xFu; }
#define XB_SPIN(cond, bar) do { unsigned _sp = 0; while (cond) { __builtin_amdgcn_s_sleep(1); \
    if ((++_sp & 255u) == 0u) { if (xb_ld(&(bar)[XB_TMO])) break; if (_sp > XB_SPIN_CAP) { atomicAdd(&(bar)[XB_TMO], 1u); break; } } } } while (0)
__device__ __forceinline__ void xcd_barrier_complete(unsigned* bar, unsigned x, unsigned G, unsigned& nloc, unsigned& nx) {
    unsigned sum, cnt, mine, sp = 0u;
    for (;;) {
        sum = 0u; cnt = 0u; mine = 0u;
#pragma unroll
        for (unsigned j = 0; j < 16; ++j) { const unsigned c = xb_ld(&bar[XB_XCNT(j)]); sum += c; cnt += (c > 0u) ? 1u : 0u; mine = (j == x) ? c : mine; }
        if (sum == G) break;
        __builtin_amdgcn_s_sleep(1);
        if ((++sp & 255u) == 0u) { if (xb_ld(&bar[XB_TMO])) break; if (sp > XB_SPIN_CAP) { atomicAdd(&bar[XB_TMO], 1u); break; } }
    }
    nloc = mine > 0u ? mine : 1u; nx = cnt > 0u ? cnt : 1u;
}
__device__ __forceinline__ void grid_barrier(unsigned* bar, volatile __attribute__((address_space(3))) unsigned* st, unsigned G, int tid) {
    asm volatile("s_waitcnt vmcnt(0)" ::: "memory");
    __syncthreads();
    if (tid == 0) {
        __builtin_amdgcn_s_waitcnt(0);
        const unsigned x = xb_xcc_id();
        unsigned nloc = st[0], nx = st[1];
        if (nloc == 0u) { xcd_barrier_complete(bar, x, G, nloc, nx); st[0] = nloc; st[1] = nx; }
        const unsigned old = xb_add(&bar[XB_XSUB(x)], 1u);
        const unsigned gen = old / nloc;
        if (old + 1u == (gen + 1u) * nloc) {
            __builtin_amdgcn_fence(__ATOMIC_RELEASE, "agent");
            asm volatile("s_waitcnt vmcnt(0)" ::: "memory");
            const unsigned og = xb_add(&bar[XB_TOP], 1u);
            const unsigned tg = og / nx;
            if (og + 1u == (tg + 1u) * nx) xb_add(&bar[XB_TOPGEN], 1u);
            else XB_SPIN(xb_ld(&bar[XB_TOPGEN]) == tg, bar);
            __builtin_amdgcn_fence(__ATOMIC_ACQUIRE, "agent");
            xb_add(&bar[XB_XGEN(x)], 1u);
            asm volatile("s_waitcnt vmcnt(0)" ::: "memory");
        } else {
            XB_SPIN(xb_ld(&bar[XB_XGEN(x)]) == gen, bar);
            __builtin_amdgcn_fence(__ATOMIC_ACQUIRE, "agent");
            asm volatile("s_waitcnt vmcnt(0)" ::: "memory");
        }
    }
    __syncthreads();
}
typedef const __attribute__((address_space(4))) Params* KP;
__device__ __forceinline__ Params load_params(KP kp) {
#if defined(__HIP_DEVICE_COMPILE__)
    return *kp;
#else
    return Params{};
#endif
}
#define PH_HEADER() \
        KP kp = (KP)__builtin_amdgcn_kernarg_segment_ptr(); asm volatile("" : "+s"(kp)); Params p = load_params(kp); \
         \
        unsigned char* ws = p.ws; asm volatile("" : "+s"(ws)); int tid = wid_s * 64 + (int)__builtin_amdgcn_mbcnt_hi(~0u, __builtin_amdgcn_mbcnt_lo(~0u, 0u)); asm volatile("" : "+v"(tid)); \
        const int wid = tid >> 6, lane = tid & 63, gw = bid * 8 + wid, NGW = G * 8; \
        bf16_t* W_in = (bf16_t*)(ws + WS_WIN); bf16_t* W_q = (bf16_t*)(ws + WS_WQ); bf16_t* W_kv = (bf16_t*)(ws + WS_WKV); bf16_t* W_lw = (bf16_t*)(ws + WS_LW); bf16_t* W_la = (bf16_t*)(ws + WS_LA); \
        bf16_t* W_bm = (bf16_t*)(ws + WS_WBM); bf16_t* W_br = (bf16_t*)(ws + WS_WBR); bf16_t* W_out = (bf16_t*)(ws + WS_WOUT); \
        float* cs = (float*)(ws + WS_CS); float* ssq = (float*)(ws + WS_SSQ); \
        bf16_t* hbuf = (bf16_t*)(ws + WS_H); bf16_t* qa = (bf16_t*)(ws + WS_QA); bf16_t* kva = (bf16_t*)(ws + WS_KVA); bf16_t* misc = (bf16_t*)(ws + WS_MISC); bf16_t* krope = (bf16_t*)(ws + WS_KROPE); \
        bf16_t* rkv = (bf16_t*)(ws + WS_RKV); bf16_t* zb = (bf16_t*)(ws + WS_Z); bf16_t* gb = (bf16_t*)p.out; bf16_t* qb = (bf16_t*)(ws + WS_Q); bf16_t* kvb = (bf16_t*)(ws + WS_KV); \
        bf16_t* Aw = (bf16_t*)(ws + WS_AW); bf16_t* Aa = (bf16_t*)(ws + WS_AA); unsigned short* ua = (unsigned short*)(ws + WS_UA); \
        float* tmp = (float*)(ws + WS_TMP); bf16_t* merged = (bf16_t*)(ws + WS_MERGED); \
        PG8_LAS unsigned char* glds = (PG8_LAS unsigned char*)shm; \
        pg8::StaticOrder S;
__global__ void __launch_bounds__(512) hybrid_fwd(Params p_arg) {
    extern __shared__ __attribute__((aligned(16))) char shm[];
    cg::grid_group grid = cg::this_grid();
    const int G = gridDim.x, bid = blockIdx.x;
    const int wid_s = __builtin_amdgcn_readfirstlane((int)threadIdx.x >> 6);
    const int ph_lo = p_arg.ph_lo, ph_hi = p_arg.ph_hi;
    volatile __attribute__((address_space(3))) unsigned* xb_st = (volatile __attribute__((address_space(3))) unsigned*)(shm + LDS_PHASE_BYTES);
    if (ph_hi - ph_lo > 1) {
        if (threadIdx.x == 0) { xb_st[0] = 0u; xb_st[1] = 0u; (void)xb_add((unsigned*)(p_arg.ws + WS_BAR) + XB_XCNT(xb_xcc_id()), 1u); }
        grid.sync();
    }
        if (PHEN(0) && ph_lo <= 0 && 0 < ph_hi) { PH_HEADER();
        for (int rep_ = 0; rep_ < DBLN(0); ++rep_) {
            for (int it = bid; it < T_IN; it += G) transpose_tile(p.w_in, DIN, 2048, W_in, 1, nullptr, it, (float*)shm, tid);
            for (int i = bid * 512 + tid; i < 2 * 2048 * 32; i += G * 512) { const int which = i >> 16, rem = i & 65535, kg = rem >> 11, n = rem & 2047, k0 = kg * 8;
                float v[8] = {0.f, 0.f, 0.f, 0.f, 0.f, 0.f, 0.f, 0.f}; const float* sp = nullptr;
                if (n < 1024) { if (k0 < 96) sp = (which ? p.a2_f : p.w2_f) + (size_t)k0 * 1024 + n; } else { if (k0 >= 128 && k0 < 224) sp = (which ? p.a2_b : p.w2_b) + (size_t)(k0 - 128) * 1024 + (n - 1024); }
                if (sp) {
#pragma unroll
                    for (int e = 0; e < 8; ++e) v[e] = sp[(size_t)e * 1024]; }
                *(u32x4*)((which ? W_la : W_lw) + (size_t)n * 256 + k0) = pack8(v); }
            for (int i = bid * 512 + tid; i < SEQ * 32; i += G * 512) { const int pos = i >> 5, fi = i & 31; const float inv = exp2f(-(float)fi * (13.287712379549449f / 32.f)); const float ang = (float)pos * inv;
                double rev = (double)ang * 0.15915494309189535; rev -= floor(rev); const float rf = (float)rev;
                cs[2 * i] = __builtin_amdgcn_cosf(rf); cs[2 * i + 1] = __builtin_amdgcn_sinf(rf); }
            f32x4 gpre[4][2];
#pragma unroll
            for (int j = 0; j < 4; ++j)
#pragma unroll
                for (int hh = 0; hh < 2; ++hh) gpre[j][hh] = *(const f32x4*)(p.g_pre + (j * 64 + lane) * 8 + hh * 4);
            for (int row = gw; row < T; row += NGW) { const float* xr = p.x + (size_t)row * DM; f32x4 v[4][2]; float s = 0.f;
#pragma unroll
                for (int j = 0; j < 4; ++j)
#pragma unroll
                    for (int hh = 0; hh < 2; ++hh) { v[j][hh] = *(const f32x4*)(xr + (j * 64 + lane) * 8 + hh * 4); s += (v[j][hh][0] * v[j][hh][0] + v[j][hh][1] * v[j][hh][1]) + (v[j][hh][2] * v[j][hh][2] + v[j][hh][3] * v[j][hh][3]); }
                const float rs = rsqrtf(wave_sum_fast(s) * (1.f / DM) + 1e-6f);
#pragma unroll
                for (int j = 0; j < 4; ++j) { float o[8];
#pragma unroll
                    for (int e = 0; e < 4; ++e) { o[e] = v[j][0][e] * rs * gpre[j][0][e]; o[4 + e] = v[j][1][e] * rs * gpre[j][1][e]; }
                    *(u32x4*)(hbuf + (size_t)row * DM + (j * 64 + lane) * 8) = pack8(o); } }

        } }
        if (PHEN(1) && ph_lo <= 1 && 1 < ph_hi) { PH_HEADER(); if (1 > ph_lo) grid_barrier((unsigned*)(ws + WS_BAR), xb_st, (unsigned)G, tid);
        for (int rep_ = 0; rep_ < DBLN(1); ++rep_) {
            S.init(T, NP1, G, bid); Epi1 E{qa, kva, misc, krope, rkv, zb, gb, ssq, cs};
            pg8::gemm_phase(glds, pg8::Gemm{hbuf, W_in, T, NP1, 2048, 2048, 2048}, S, E, tid);
            if (bid >= G / 2) for (int it = bid - G / 2; it < T_REST; it += G - G / 2) { int r = it; float* tl = (float*)shm;
                if (r < T_Q) { transpose_tile(p.wq_b, 1536, 512, W_q, 2, p.q_norm, r, tl, tid); continue; } r -= T_Q;
                if (r < T_KV) { transpose_tile(p.wkv_b, 2048, 512, W_kv, 0, p.kv_norm, r, tl, tid); continue; } r -= T_KV;
                if (r < T_BM) { transpose_tile(p.w_br_mla, 2048, 1024, W_bm, 0, nullptr, r, tl, tid, 2048); continue; } r -= T_BM;
                if (r < T_BM) { transpose_tile(p.w_br_rwkv, 2048, 1024, W_bm + 1024, 0, nullptr, r, tl, tid, 2048); continue; } r -= T_BM;
                transpose_tile(p.w_out, 2048, 2048, W_out, 0, nullptr, r, tl, tid); }

        } }
        if (PHEN(2) && ph_lo <= 2 && 2 < ph_hi) { PH_HEADER(); if (2 > ph_lo) grid_barrier((unsigned*)(ws + WS_BAR), xb_st, (unsigned)G, tid);
        for (int rep_ = 0; rep_ < DBLN(2); ++rep_) {
            { S.init(T, 1536, G, bid); EpiQ E{qb, ssq, cs}; pg8::gemm_phase(glds, pg8::Gemm{qa, W_q, T, 1536, 512, 512, 512}, S, E, tid); }
            { S.init(T, 2048, G, bid); EpiKV E{kvb, ssq}; pg8::gemm_phase(glds, pg8::Gemm{kva, W_kv, T, 2048, 512, 512, 512}, S, E, tid); }
            { const int c = tid & 63, isA = c >> 5, cc = (c & 31) * 8, half = cc >> 7, kc = cc & 127;
              const bool live = kc < 96; const int mcol = 64 + isA * 192 + half * 96 + kc;
              float mu8[8];
#pragma unroll
              for (int e = 0; e < 8; ++e) mu8[e] = live ? p.mu[3072 + isA * 192 + half * 96 + kc + e] : 0.f;
              bf16_t* dstb = (isA ? Aa : Aw) + cc;
              for (int row = bid * 8 + (tid >> 6); row < T; row += G * 8) { const int t = row & (SEQ - 1); u32x4 outv = {0u, 0u, 0u, 0u};
                  if (live) { const bf16_t* mp = misc + (size_t)row * 512 + mcol; float o[8], x0[8], xm[8], xp[8];
                      unpack8(*(const u32x4*)mp, x0); unpack8(t > 0 ? *(const u32x4*)(mp - 512) : (u32x4){0u, 0u, 0u, 0u}, xm); unpack8(t < SEQ - 1 ? *(const u32x4*)(mp + 512) : (u32x4){0u, 0u, 0u, 0u}, xp);
#pragma unroll
                      for (int e = 0; e < 8; ++e) { const float xs = x0[e] + mu8[e] * (0.5f * (xm[e] + xp[e]) - x0[e]); o[e] = isA ? xs : 1.f - 2.f * __builtin_amdgcn_rcpf(1.f + __expf(2.f * xs)); }
                      outv = pack8(o); }
                  *(u32x4*)(dstb + (size_t)row * 256) = outv; } }

        } }
        if (PHEN(3) && ph_lo <= 3 && 3 < ph_hi) { PH_HEADER(); if (3 > ph_lo) grid_barrier((unsigned*)(ws + WS_BAR), xb_st, (unsigned)G, tid);
            for (int i = 0; i * G + bid < 512; ++i) { const int L = i * G + bid; int b, h, qblk;
                if (G == 256) { const int xcd = bid & 7, sI = bid >> 3, idx = i * 32 + sI, pl = idx >> 3; qblk = idx & 7; const int pair = pl * 8 + xcd; b = pair >> 3; h = pair & 7; }
                else { qblk = L & 7; h = (L >> 3) & 7; b = L >> 6; }
                const size_t tok0 = (size_t)b * SEQ;
                att::attn_body(qb + (tok0 + qblk * 256) * 1536 + h * 192, kvb + tok0 * 2048 + h * 256, kvb + tok0 * 2048 + h * 256 + 128, krope + tok0 * 64,
                               zb + (tok0 + qblk * 256) * 2048 + h * 128, SEQ, shm, tid); }
            __syncthreads();
#ifndef NO_LORA
            { S.init(T, 2048, G, bid); EpiLora E{ua, 0, p.w0_f, p.w0_b}; pg8::gemm_phase(glds, pg8::Gemm{Aw, W_lw, T, 2048, 256, 256, 256}, S, E, tid); }
            { S.init(T, 2048, G, bid); EpiLora E{ua, 2048, p.a0_f, p.a0_b}; pg8::gemm_phase(glds, pg8::Gemm{Aa, W_la, T, 2048, 256, 256, 256}, S, E, tid); }
#endif
        }
        if (PHEN(4) && ph_lo <= 4 && 4 < ph_hi) { PH_HEADER(); if (4 > ph_lo) grid_barrier((unsigned*)(ws + WS_BAR), xb_st, (unsigned)G, tid);
        for (int rep_ = 0; rep_ < DBLN(4); ++rep_) {
            for (int c = bid; c < 256; c += G) scan_chain(p, c, shm, tid);

        } }
        if (PHEN(5) && ph_lo <= 5 && 5 < ph_hi) { PH_HEADER(); if (5 > ph_lo) grid_barrier((unsigned*)(ws + WS_BAR), xb_st, (unsigned)G, tid);
            const float* __restrict__ yf = (const float*)(ws + WS_YF); const float* __restrict__ yb = (const float*)(ws + WS_YB);
            const int c4 = (lane >> 4) * 64 + (lane & 15) * 4;
            P5Par pp; { const int chq = (gw & 3) * 256 + c4;
                pp.mur = *(const f32x4*)(p.mu + chq); pp.muk = *(const f32x4*)(p.mu + 1024 + chq); pp.muv = *(const f32x4*)(p.mu + 2048 + chq); pp.ka = *(const f32x4*)(p.k_a + chq); pp.rk = *(const f32x4*)(p.r_k + chq);
                pp.gg = *(const f32x4*)(p.gn_g + chq); pp.gb = *(const f32x4*)(p.gn_b + chq); }
            for (int it0 = gw; it0 < T * 4; it0 += 5 * NGW) {
                P5In in[5];
#pragma unroll
                for (int k = 0; k < 5; ++k) { const int it = it0 + k * NGW; if (it < T * 4) p5_load(in[k], it, c4, yf, yb, rkv, ua, zb); }
#pragma unroll
                for (int k = 0; k < 5; ++k) { const int it = it0 + k * NGW; if (it < T * 4) p5_finish(in[k], it, c4, pp, zb); }
            }
        }
        if (PHEN(6) && ph_lo <= 6 && 6 < ph_hi) { PH_HEADER(); if (6 > ph_lo) grid_barrier((unsigned*)(ws + WS_BAR), xb_st, (unsigned)G, tid);
        for (int rep_ = 0; rep_ < DBLN(6); ++rep_) {
            { S.init(T, 2048, G, bid); EpiMerge E{gb, merged}; pg8::gemm_phase(glds, pg8::Gemm{zb, W_bm, T, 2048, 2048, 2048, 2048}, S, E, tid); }

        } }
        if (PHEN(7) && ph_lo <= 7 && 7 < ph_hi) { PH_HEADER(); if (7 > ph_lo) grid_barrier((unsigned*)(ws + WS_BAR), xb_st, (unsigned)G, tid);
        for (int rep_ = 0; rep_ < DBLN(7); ++rep_) {
            S.init(T, 2048, G, bid); EpiOut E{(bf16_t*)(ws + WS_ORAW)}; pg8::gemm_phase(glds, pg8::Gemm{merged, W_out, T, 2048, 2048, 2048, 2048}, S, E, tid);

        } }
        if (PHEN(8) && ph_lo <= 8 && 8 < ph_hi) { PH_HEADER(); if (8 > ph_lo) grid_barrier((unsigned*)(ws + WS_BAR), xb_st, (unsigned)G, tid);
            const bf16_t* oraw = (const bf16_t*)(ws + WS_ORAW);
            f32x4 gpost[4][2];
#pragma unroll
            for (int j = 0; j < 4; ++j)
#pragma unroll
                for (int hh = 0; hh < 2; ++hh) gpost[j][hh] = *(const f32x4*)(p.g_post + (j * 64 + lane) * 8 + hh * 4);
            for (int row = gw; row < T; row += NGW) { float* orow = p.out + (size_t)row * DM; const float* xr = p.x + (size_t)row * DM; float v[4][8]; float s = 0.f;
                u32x4 ow[4]; f32x4 xx[4][2];
#pragma unroll
                for (int j = 0; j < 4; ++j) { ow[j] = *(const u32x4*)(oraw + (size_t)row * DM + (j * 64 + lane) * 8);
#pragma unroll
                    for (int hh = 0; hh < 2; ++hh) xx[j][hh] = *(const f32x4*)(xr + (j * 64 + lane) * 8 + hh * 4); }
#pragma unroll
                for (int j = 0; j < 4; ++j) { unpack8(ow[j], v[j]);
#pragma unroll
                    for (int e = 0; e < 8; ++e) s += v[j][e] * v[j][e]; }
                const float rs = rsqrtf(wave_sum_fast(s) * (1.f / DM) + 1e-6f);
#pragma unroll
                for (int j = 0; j < 4; ++j) { const int c = (j * 64 + lane) * 8;
#pragma unroll
                    for (int hh = 0; hh < 2; ++hh) { const f32x4 gg = gpost[j][hh], xv = xx[j][hh];
                        *(f32x4*)(orow + c + hh * 4) = (f32x4){xv[0] + v[j][hh * 4 + 0] * rs * gg[0], xv[1] + v[j][hh * 4 + 1] * rs * gg[1], xv[2] + v[j][hh * 4 + 2] * rs * gg[2], xv[3] + v[j][hh * 4 + 3] * rs * gg[3]}; } } }
        }
}

constexpr int LDS_BYTES = LDS_PHASE_BYTES + 16;
constexpr int NPH = 9;
extern "C" void kernel_launch(void* const* d_in, const int* in_sizes, int n_in, void* d_out, int out_size, void* d_ws, size_t ws_size, hipStream_t stream) {
    static int grid = 0;
    if (grid == 0) {
        if (n_in != 25 || out_size != T * DM || ws_size < WS_END) { fprintf(stderr, "kernel_launch: shape mismatch n_in %d out %d ws %zu (need %zu)\n", n_in, out_size, ws_size, (size_t)WS_END); grid = -1; return; }
        int dev = 0, cus = 0, per_cu = 0;
        if (hipGetDevice(&dev) != hipSuccess || hipDeviceGetAttribute(&cus, hipDeviceAttributeMultiprocessorCount, dev) != hipSuccess) { grid = -1; return; }
        if (hipFuncSetAttribute((const void*)hybrid_fwd, hipFuncAttributeMaxDynamicSharedMemorySize, LDS_BYTES) != hipSuccess) { fprintf(stderr, "kernel_launch: hipFuncSetAttribute failed\n"); grid = -1; return; }
        if (hipOccupancyMaxActiveBlocksPerMultiprocessor(&per_cu, (const void*)hybrid_fwd, 512, LDS_BYTES) != hipSuccess || per_cu < 1) { fprintf(stderr, "kernel_launch: occupancy query says %d\n", per_cu); grid = -1; return; }
        grid = cus;
    }
    if (grid < 0) return;
    Params p{};
    const float** pp = (const float**)&p;
    for (int i = 0; i < 25; ++i) pp[i] = (const float*)d_in[i];
    p.out = (float*)d_out; p.ws = (unsigned char*)d_ws;
    if (hipMemsetAsync((char*)d_ws + WS_BAR, 0, 16384, stream) != hipSuccess) { fprintf(stderr, "kernel_launch: memset failed\n"); return; }
#if N_LAUNCHES == 1
    p.ph_lo = 0; p.ph_hi = NPH;
    void* args[] = {&p};
    hipError_t e = hipLaunchCooperativeKernel((const void*)hybrid_fwd, dim3(grid), dim3(512), args, LDS_BYTES, stream);
    if (e != hipSuccess) fprintf(stderr, "cooperative launch failed: %s (grid %d)\n", hipGetErrorString(e), grid);
#else
    for (int ph = 0; ph < NPH; ++ph) { p.ph_lo = ph; p.ph_hi = ph + 1; hipLaunchKernelGGL(hybrid_fwd, dim3(grid), dim3(512), LDS_BYTES, stream, p); }
#endif
}
```

```cpp
#include <hip/hip_runtime.h>
#include <hip/hip_cooperative_groups.h>
#include <cstdio>
#include <cstdint>
namespace cg = cooperative_groups;

#ifndef PH_MASK
#define PH_MASK 0x1ff
#endif
#define PHEN(i) ((PH_MASK >> (i)) & 1)
#ifndef DBL_MASK
#define DBL_MASK 0
#endif
#define DBLN(i) (1 + ((DBL_MASK >> (i)) & 1))
#ifndef N_LAUNCHES
#define N_LAUNCHES 1
#endif

constexpr int T = 16384, SEQ = 2048, DM = 2048, DIN = 10688;
constexpr int NP1 = 10752;
constexpr size_t MiB = 1u << 20;
constexpr size_t WS_WQ = 0, WS_WKV = WS_WQ + 1536 * 512 * 2, WS_LW = WS_WKV + 2048 * 512 * 2, WS_LA = WS_LW + 2048 * 256 * 2, WS_WBM = WS_LA + 2048 * 256 * 2,
                 WS_WBR = WS_WBM + 2048 * 1024 * 2, WS_WOUT = WS_WBR + 2048 * 1024 * 2, WS_CS = WS_WOUT + 2048 * 2048 * 2, WS_SSQ = WS_CS + 2048 * 32 * 8,
                 WS_SMALL_END = WS_SSQ + (size_t)T * 16 * 4;
static_assert(WS_SMALL_END <= 23 * MiB, "small region");
constexpr size_t WS_RKV = 23 * MiB, WS_Z = 119 * MiB, WS_KROPE = 183 * MiB, WS_H = 185 * MiB  , WS_Q = WS_H, WS_AW = 233 * MiB, WS_AA = 241 * MiB,
                 WS_KV = 249 * MiB  , WS_WIN = 313 * MiB, WS_QA = 355 * MiB, WS_KVA = 371 * MiB, WS_MISC = 387 * MiB, WS_UA = 313 * MiB  ,
                 WS_YF = 185 * MiB, WS_YB = 249 * MiB, WS_TMP = 313 * MiB, WS_MERGED = 185 * MiB, WS_ORAW = 313 * MiB  , WS_BAR = 441 * MiB, WS_END = 441 * MiB + 16384;

typedef unsigned short bf16_t;
typedef short bf16x8 __attribute__((ext_vector_type(8)));
typedef short s16x4 __attribute__((ext_vector_type(4)));
typedef float f32x4 __attribute__((ext_vector_type(4)));
typedef float f32x16 __attribute__((ext_vector_type(16)));
typedef unsigned u32x4 __attribute__((ext_vector_type(4)));
typedef float f32x2 __attribute__((ext_vector_type(2)));

struct Params {
    const float *x, *g_pre, *w_in, *q_norm, *wq_b, *kv_norm, *wkv_b, *mu, *w0_f, *w2_f, *w0_b, *w2_b, *a0_f, *a2_f, *a0_b, *a2_b, *k_k, *k_a, *r_k, *gn_g, *gn_b, *w_br_mla, *w_br_rwkv, *w_out, *g_post;
    float* out; unsigned char* ws; int ph_lo, ph_hi;
};

__device__ __forceinline__ unsigned cvt_pk_bf16(float lo, float hi) { unsigned r; asm volatile("v_cvt_pk_bf16_f32 %0, %1, %2" : "=v"(r) : "v"(lo), "v"(hi)); return r; }
__device__ __forceinline__ float bf2f(bf16_t b) { return __uint_as_float(((unsigned)b) << 16); }
__device__ __forceinline__ bf16_t f2bf(float f) { return (bf16_t)(cvt_pk_bf16(f, 0.f) & 0xffffu); }
__device__ __forceinline__ float h2f(unsigned short h) { _Float16 v; __builtin_memcpy(&v, &h, 2); return (float)v; }
__device__ __forceinline__ unsigned pk_f16(float a, float b) { _Float16 x = (_Float16)a, y = (_Float16)b; unsigned short xs, ys; __builtin_memcpy(&xs, &x, 2); __builtin_memcpy(&ys, &y, 2); return (unsigned)xs | ((unsigned)ys << 16); }
__device__ __forceinline__ float sigmoidf_(float v) { return __builtin_amdgcn_rcpf(1.f + __expf(-v)); }
__device__ __forceinline__ float wave_sum(float v) {
#pragma unroll
    for (int o = 1; o < 64; o <<= 1) v += __shfl_xor(v, o);
    return v;
}
template <int CTRL> __device__ __forceinline__ float dppx(float v) { return __int_as_float(__builtin_amdgcn_update_dpp(0, __float_as_int(v), CTRL, 0xF, 0xF, true)); }
__device__ __forceinline__ float red8(float v) { v += dppx<0xB1>(v); v += dppx<0x4E>(v); v += dppx<0x141>(v); return v; }
__device__ __forceinline__ float red16(float v) { v = red8(v); v += dppx<0x140>(v); return v; }
__device__ __forceinline__ float wave_sum_fast(float v) { v = red16(v); const int iv = __float_as_int(v);
    return (__int_as_float(__builtin_amdgcn_readlane(iv, 0)) + __int_as_float(__builtin_amdgcn_readlane(iv, 16))) + (__int_as_float(__builtin_amdgcn_readlane(iv, 32)) + __int_as_float(__builtin_amdgcn_readlane(iv, 48))); }
typedef unsigned u32x2 __attribute__((ext_vector_type(2)));
__device__ __forceinline__ void unpack4(u32x2 w, float* v) { v[0] = __uint_as_float(w.x << 16); v[1] = __uint_as_float(w.x & 0xffff0000u); v[2] = __uint_as_float(w.y << 16); v[3] = __uint_as_float(w.y & 0xffff0000u); }
__device__ __forceinline__ void unpack4h(u32x2 w, float* v) { v[0] = h2f((unsigned short)(w.x & 0xffffu)); v[1] = h2f((unsigned short)(w.x >> 16)); v[2] = h2f((unsigned short)(w.y & 0xffffu)); v[3] = h2f((unsigned short)(w.y >> 16)); }
__device__ __forceinline__ u32x4 pack8(const float* v) { u32x4 w; w.x = cvt_pk_bf16(v[0], v[1]); w.y = cvt_pk_bf16(v[2], v[3]); w.z = cvt_pk_bf16(v[4], v[5]); w.w = cvt_pk_bf16(v[6], v[7]); return w; }
__device__ __forceinline__ void unpack8(u32x4 w, float* v) {
    v[0] = __uint_as_float(w.x << 16); v[1] = __uint_as_float(w.x & 0xffff0000u); v[2] = __uint_as_float(w.y << 16); v[3] = __uint_as_float(w.y & 0xffff0000u);
    v[4] = __uint_as_float(w.z << 16); v[5] = __uint_as_float(w.z & 0xffff0000u); v[6] = __uint_as_float(w.w << 16); v[7] = __uint_as_float(w.w & 0xffff0000u);
}

namespace pg8 {
#define PG8_LAS __attribute__((address_space(3)))
constexpr int BM = 256, BK = 64, HALF = 128, HTB = HALF * BK * 2, STAGE_BYTES = 8 * HTB, NXCD = 8, WGM = 8;
__host__ __device__ __forceinline__ int lds_byte(int r, int c) { const int st = (r >> 4) * 2 + (c >> 5), rr = r & 15, cc = c & 31, ob = rr * 64 + cc * 2; return st * 1024 + (ob ^ (((ob >> 9) & 1) << 5)); }
__host__ __device__ __forceinline__ void stage_rc(int b, int& R, int& C) { const int st = b / 1024, sb = b % 1024, swz = sb ^ (((sb >> 9) & 1) << 5); R = (st >> 1) * 16 + swz / 64; C = (st & 1) * 32 + (swz % 64) / 2; }
__host__ __device__ __forceinline__ int perm32(int rho) { const int n = rho >> 4, i = rho & 15; return 8 * (i >> 2) + 4 * n + (i & 3); }
struct Unit { int pm, pn; };
struct Gemm { const bf16_t* A; const bf16_t* Bt; int M, N, K, lda, ldb; };
struct StaticOrder {
    int nM, nN, nwg, G, c;
    __host__ __device__ void init(int M, int N, int G_, int c_) { nM = M / BM; nN = N / BM; nwg = nM * nN; G = G_; c = c_; }
    __host__ __device__ bool next(int i, Unit& u) const {
        const long L = (long)i * G + c; if (L >= nwg) return false;
        int wgid = (int)L; { const int q = nwg / NXCD, r = nwg % NXCD, xcd = wgid % NXCD, off = wgid / NXCD; wgid = (xcd < r ? xcd * (q + 1) : r * (q + 1) + (xcd - r) * q) + off; }
        const int nig = WGM * nN, gid = wgid / nig, fm = gid * WGM, gsz = (nM - fm) < WGM ? (nM - fm) : WGM;
        u.pm = fm + ((wgid % nig) % gsz); u.pn = (wgid % nig) / gsz; return true;
    }
    __device__ __forceinline__ void a_ready(const Unit&) const {}
    __device__ __forceinline__ void done(const Unit&) const {}
};
template <class Epi, class Sched>
__device__ __forceinline__ void gemm_phase(PG8_LAS unsigned char* lds, const Gemm g, const Sched& S, const Epi& E, int tid_in) {
    int tid_l = tid_in; asm volatile("" : "+v"(tid_l));
    const int tid = tid_l, wid = __builtin_amdgcn_readfirstlane(tid >> 6), lane = tid & 63, wr = wid >> 2, wc = wid & 3, fr = lane & 15, fq = lane >> 4;
    const int K = g.K, nt = K / BK;
    unsigned voffA[2], voffB[2];
#pragma unroll
    for (int i = 0; i < 2; ++i) { int R, C; stage_rc(tid * 16 + i * 8192, R, C); const int Rb = Epi::PERM ? ((R & ~31) + perm32(R & 31)) : R;
        voffA[i] = (unsigned)(R * g.lda + C) * 2u; voffB[i] = (unsigned)(Rb * g.ldb + C) * 2u; }
    const size_t kstep = (size_t)(BK * 2);
    const size_t hstepA = (size_t)HALF * g.lda * 2, hstepB = (size_t)HALF * g.ldb * 2;
    const size_t tstepA = 2 * hstepA, tstepB = 2 * hstepB;
    const unsigned ldsw = (unsigned)wid * 1024u;
    const int aoff = lds_byte(wr * 64 + fr, fq * 8), boff = lds_byte(wc * 32 + fr, fq * 8);
#define PG8_SA(b, h) (((b) * 2 + (h)) * HTB)
#define PG8_SB(b, h) ((4 + (b) * 2 + (h)) * HTB)
#define PG8_STAGE(bufoff, gbase, voff) do { _Pragma("unroll") for (int _i = 0; _i < 2; ++_i) \
        __builtin_amdgcn_global_load_lds((const unsigned*)((const char*)(gbase) + (voff)[_i]), (PG8_LAS unsigned*)(lds + (bufoff) + ldsw + _i * 8192), 16, 0, 0); } while (0)
#define PG8_LDA(dst, b, h) do { _Pragma("unroll") for (int m = 0; m < 4; ++m) _Pragma("unroll") for (int k = 0; k < 2; ++k) dst[m][k] = *(const PG8_LAS bf16x8*)(lds + PG8_SA(b, h) + aoff + m * 2048 + k * 1024); } while (0)
#define PG8_LDB(dst, b, h) do { _Pragma("unroll") for (int n = 0; n < 2; ++n) _Pragma("unroll") for (int k = 0; k < 2; ++k) dst[n][k] = *(const PG8_LAS bf16x8*)(lds + PG8_SB(b, h) + boff + n * 2048 + k * 1024); } while (0)
#define PG8_MMA(ai, bj, At, Bt) do { __builtin_amdgcn_s_setprio(1); _Pragma("unroll") for (int m = 0; m < 4; ++m) _Pragma("unroll") for (int n = 0; n < 2; ++n) _Pragma("unroll") for (int k = 0; k < 2; ++k) \
        acc[ai][bj][m][n] = __builtin_amdgcn_mfma_f32_16x16x32_bf16(Bt[n][k], At[m][k], acc[ai][bj][m][n], 0, 0, 0); __builtin_amdgcn_s_setprio(0); } while (0)
#define PG8_WAIT_V(n) asm volatile("s_waitcnt vmcnt(" #n ")" ::: "memory")
#define PG8_WAIT_L(n) asm volatile("s_waitcnt lgkmcnt(" #n ")" ::: "memory")
#define PG8_BAR __builtin_amdgcn_s_barrier()
#define PG8_SCHED __builtin_amdgcn_sched_barrier(0)
    Unit cur, nxt; int ui = 0;
    if (!S.next(0, cur)) return;
    f32x4 acc[2][2][4][2];
#pragma unroll
    for (int a = 0; a < 2; ++a)
#pragma unroll
        for (int b = 0; b < 2; ++b)
#pragma unroll
            for (int m = 0; m < 4; ++m)
#pragma unroll
                for (int n = 0; n < 2; ++n) acc[a][b][m][n] = (f32x4){0.f, 0.f, 0.f, 0.f};
    bf16x8 At[4][2], B0[2][2], B1[2][2];
    const char* cA = (const char*)g.A + (size_t)cur.pm * tstepA; const char* cB = (const char*)g.Bt + (size_t)cur.pn * tstepB;
    S.a_ready(cur);
    PG8_STAGE(PG8_SB(0, 0), cB, voffB); PG8_STAGE(PG8_SA(0, 0), cA, voffA); PG8_STAGE(PG8_SB(0, 1), cB + hstepB, voffB); PG8_STAGE(PG8_SA(0, 1), cA + hstepA, voffA);
    if (wr == 1) PG8_BAR;
    PG8_WAIT_V(4); PG8_BAR;
    PG8_STAGE(PG8_SB(1, 0), cB + kstep, voffB); PG8_STAGE(PG8_SA(1, 0), cA + kstep, voffA); PG8_STAGE(PG8_SB(1, 1), cB + hstepB + kstep, voffB);
    PG8_WAIT_V(6); PG8_BAR;
    for (;;) {
        const bool has_next = S.next(ui + 1, nxt);
        const char* nA = has_next ? (const char*)g.A + (size_t)nxt.pm * tstepA : cA; const char* nB = has_next ? (const char*)g.Bt + (size_t)nxt.pn * tstepB : cB;
        for (int t = 0; t < nt; t += 2) {
            const bool last = (t == nt - 2);
            const char* a1 = cA + (size_t)(t + 1) * kstep;
            const char* a2 = last ? nA : cA + (size_t)(t + 2) * kstep; const char* b2 = last ? nB : cB + (size_t)(t + 2) * kstep;
            const char* a3 = a2 + kstep; const char* b3 = b2 + kstep;
            if (last && has_next) S.a_ready(nxt);
            if constexpr (Epi::MID) { if (t == (nt >> 1)) E.mid(acc, cur, wr, wc, fr, fq); }
            PG8_LDB(B0, 0, 0); PG8_SCHED; PG8_LDA(At, 0, 0); PG8_STAGE(PG8_SA(1, 1), a1 + hstepA, voffA);
            PG8_WAIT_L(8); PG8_BAR; PG8_WAIT_L(0); PG8_MMA(0, 0, At, B0); PG8_BAR; PG8_SCHED;
            PG8_LDB(B1, 0, 1); PG8_STAGE(PG8_SB(0, 0), b2, voffB);
            PG8_BAR; PG8_WAIT_L(0); PG8_MMA(0, 1, At, B1); PG8_BAR;
            PG8_LDA(At, 0, 1); PG8_STAGE(PG8_SA(0, 0), a2, voffA);
            PG8_BAR; PG8_WAIT_L(0); PG8_MMA(1, 0, At, B0); PG8_BAR; PG8_SCHED;
            PG8_STAGE(PG8_SB(0, 1), b2 + hstepB, voffB);
            PG8_WAIT_V(6); PG8_BAR; PG8_MMA(1, 1, At, B1); PG8_BAR;
            PG8_LDB(B0, 1, 0); PG8_SCHED; PG8_LDA(At, 1, 0); PG8_STAGE(PG8_SA(0, 1), a2 + hstepA, voffA);
            PG8_WAIT_L(8); PG8_BAR; PG8_WAIT_L(0); PG8_MMA(0, 0, At, B0); PG8_BAR; PG8_SCHED;
            PG8_LDB(B1, 1, 1); PG8_STAGE(PG8_SB(1, 0), b3, voffB);
            PG8_BAR; PG8_WAIT_L(0); PG8_MMA(0, 1, At, B1); PG8_BAR;
            PG8_LDA(At, 1, 1); PG8_STAGE(PG8_SA(1, 0), a3, voffA);
            PG8_BAR; PG8_WAIT_L(0); PG8_MMA(1, 0, At, B0); PG8_BAR; PG8_SCHED;
            PG8_STAGE(PG8_SB(1, 1), b3 + hstepB, voffB);
            PG8_WAIT_V(6); PG8_BAR; PG8_MMA(1, 1, At, B1); PG8_BAR;
        }
        E(acc, cur, wr, wc, fr, fq); S.done(cur);
        if (!has_next) break;
#pragma unroll
        for (int a = 0; a < 2; ++a)
#pragma unroll
            for (int b = 0; b < 2; ++b)
#pragma unroll
                for (int m = 0; m < 4; ++m)
#pragma unroll
                    for (int n = 0; n < 2; ++n) acc[a][b][m][n] = (f32x4){0.f, 0.f, 0.f, 0.f};
        cur = nxt; cA = nA; cB = nB; ++ui;
    }
    PG8_WAIT_V(0);
    if (wr == 0) PG8_BAR;
    PG8_BAR;
#undef PG8_SA
#undef PG8_SB
#undef PG8_STAGE
#undef PG8_LDA
#undef PG8_LDB
#undef PG8_MMA
#undef PG8_WAIT_V
#undef PG8_WAIT_L
#undef PG8_BAR
#undef PG8_SCHED
}
}
using pg8::Unit;
typedef const f32x4 (&AccRef)[2][2][4][2];

#define EPI_LOOP_ROWS _Pragma("unroll") for (int ai = 0; ai < 2; ++ai) _Pragma("unroll") for (int m = 0; m < 4; ++m)
#define EPI_GET8(v) float v[8]; { const f32x4 x0 = acc[ai][bj][m][0], x1 = acc[ai][bj][m][1]; v[0] = x0[0]; v[1] = x0[1]; v[2] = x0[2]; v[3] = x0[3]; v[4] = x1[0]; v[5] = x1[1]; v[6] = x1[2]; v[7] = x1[3]; }

__device__ __forceinline__ void rope8(float* v, const float* cs, int pos, int p0) {
    const f32x4 c0 = *(const f32x4*)(cs + ((size_t)pos * 32 + p0) * 2), c1 = *(const f32x4*)(cs + ((size_t)pos * 32 + p0 + 2) * 2);
    const float co[4] = {c0[0], c0[2], c1[0], c1[2]}, si[4] = {c0[1], c0[3], c1[1], c1[3]};
#pragma unroll
    for (int q = 0; q < 4; ++q) { const float a = v[2 * q], b = v[2 * q + 1]; v[2 * q] = a * co[q] - b * si[q]; v[2 * q + 1] = a * si[q] + b * co[q]; }
}

struct Epi1 {
    static constexpr bool PERM = true, MID = false;
    bf16_t *qa, *kva, *misc, *krope, *rkv, *z, *g; float* ssq; const float* cs;
    __device__ __forceinline__ void operator()(AccRef acc, const Unit& u, int wr, int wc, int fr, int fq) const {
        const int pn = u.pn, row0 = u.pm * 256 + wr * 64 + fr, cl = wc * 32 + 8 * fq;
        if (pn < 4) {
            bf16_t* dst = pn < 2 ? qa : kva; const int cbase = (pn & 1) * 256 + cl; float* sq = ssq + (pn < 2 ? 0 : 8) + (pn & 1) * 4 + wc;
            EPI_LOOP_ROWS { __builtin_amdgcn_sched_barrier(0); const int row = row0 + ai * 128 + m * 16; float ss = 0.f;
#pragma unroll
                for (int bj = 0; bj < 2; ++bj) { EPI_GET8(v);
#pragma unroll
                    for (int j = 0; j < 8; ++j) ss += v[j] * v[j];
                    __builtin_nontemporal_store(pack8(v), (u32x4*)(dst + (size_t)row * 512 + cbase + bj * 128)); }
                ss += __shfl_xor(ss, 16); ss += __shfl_xor(ss, 32);
                if (fq == 0) sq[(size_t)row * 16] = ss; }
        } else if (pn == 4) {
            EPI_LOOP_ROWS { __builtin_amdgcn_sched_barrier(0); const int row = row0 + ai * 128 + m * 16;
#pragma unroll
                for (int bj = 0; bj < 2; ++bj) { EPI_GET8(v); const int mc = bj * 128 + cl;
                    if (mc < 64) { rope8(v, cs, row & (SEQ - 1), mc >> 1); __builtin_nontemporal_store(pack8(v), (u32x4*)(krope + (size_t)row * 64 + mc)); }
                    else __builtin_nontemporal_store(pack8(v), (u32x4*)(misc + (size_t)row * 512 + mc)); } }
        } else {
            bf16_t* dst; int ld, act;
            if (pn == 5) { dst = misc + 256; ld = 512; act = 0; }
            else if (pn < 18) { dst = rkv + (pn - 6) * 256; ld = 3072; act = 0; }
            else if (pn < 26) { dst = z + (pn - 18) * 256; ld = 2048; act = 1; }
            else { dst = g + (pn - 26) * 256; ld = 4096; act = 2; }
            dst += cl;
            EPI_LOOP_ROWS { __builtin_amdgcn_sched_barrier(0); const int row = row0 + ai * 128 + m * 16;
#pragma unroll
                for (int bj = 0; bj < 2; ++bj) { EPI_GET8(v);
                    if (act) {
#pragma unroll
                        for (int j = 0; j < 8; ++j) { const float sg = sigmoidf_(v[j]); v[j] = act == 1 ? v[j] * sg : sg; } }
                    __builtin_nontemporal_store(pack8(v), (u32x4*)(dst + (size_t)row * ld + bj * 128)); } }
        }
    }
};
__device__ __forceinline__ float rstd_from_ssq(const float* sq) { const f32x4 a = *(const f32x4*)sq, b = *(const f32x4*)(sq + 4); const float s = ((a[0] + a[1]) + (a[2] + a[3])) + ((b[0] + b[1]) + (b[2] + b[3])); return rsqrtf(s * (1.f / 512.f) + 1e-6f); }
struct EpiQ {
    static constexpr bool PERM = true, MID = false;
    bf16_t* q; const float* ssq; const float* cs;
    __device__ __forceinline__ void operator()(AccRef acc, const Unit& u, int wr, int wc, int fr, int fq) const {
        const int row0 = u.pm * 256 + wr * 64 + fr, cl = u.pn * 256 + wc * 32 + 8 * fq;
        float rsv[2][4];
        EPI_LOOP_ROWS rsv[ai][m] = rstd_from_ssq(ssq + (size_t)(row0 + ai * 128 + m * 16) * 16);
        EPI_LOOP_ROWS { __builtin_amdgcn_sched_barrier(0); const int row = row0 + ai * 128 + m * 16; const float rs = rsv[ai][m];
#pragma unroll
            for (int bj = 0; bj < 2; ++bj) { EPI_GET8(v); const int gc = cl + bj * 128, hc = gc % 192;
#pragma unroll
                for (int j = 0; j < 8; ++j) v[j] *= rs;
                if (hc >= 128) rope8(v, cs, row & (SEQ - 1), (hc - 128) >> 1);
                *(u32x4*)(q + (size_t)row * 1536 + gc) = pack8(v); } }
    }
};
struct EpiKV {
    static constexpr bool PERM = true, MID = false;
    bf16_t* kv; const float* ssq;
    __device__ __forceinline__ void operator()(AccRef acc, const Unit& u, int wr, int wc, int fr, int fq) const {
        const int row0 = u.pm * 256 + wr * 64 + fr, cl = u.pn * 256 + wc * 32 + 8 * fq;
        float rsv[2][4];
        EPI_LOOP_ROWS rsv[ai][m] = rstd_from_ssq(ssq + (size_t)(row0 + ai * 128 + m * 16) * 16 + 8);
        EPI_LOOP_ROWS { __builtin_amdgcn_sched_barrier(0); const int row = row0 + ai * 128 + m * 16; const float rs = rsv[ai][m];
#pragma unroll
            for (int bj = 0; bj < 2; ++bj) { EPI_GET8(v);
#pragma unroll
                for (int j = 0; j < 8; ++j) v[j] *= rs;
                *(u32x4*)(kv + (size_t)row * 2048 + cl + bj * 128) = pack8(v); } }
    }
};
struct EpiLora {
    static constexpr bool PERM = true, MID = false;
    unsigned short* ua; int off; const float *bias_f, *bias_b;
    __device__ __forceinline__ void operator()(AccRef acc, const Unit& u, int wr, int wc, int fr, int fq) const {
        const int row0 = u.pm * 256 + wr * 64 + fr, cl = u.pn * 256 + wc * 32 + 8 * fq; const float* bias = u.pn < 4 ? bias_f : bias_b - 1024;
        f32x4 bb[2][2];
#pragma unroll
        for (int bj = 0; bj < 2; ++bj) { bb[bj][0] = *(const f32x4*)(bias + cl + bj * 128); bb[bj][1] = *(const f32x4*)(bias + cl + bj * 128 + 4); }
#pragma unroll
        for (int bj = 0; bj < 2; ++bj) { const int gc = cl + bj * 128; const f32x4 b0 = bb[bj][0], b1 = bb[bj][1];
            EPI_LOOP_ROWS { __builtin_amdgcn_sched_barrier(0); const int row = row0 + ai * 128 + m * 16; EPI_GET8(v);
                u32x4 w; w.x = pk_f16(sigmoidf_(v[0] + b0[0]), sigmoidf_(v[1] + b0[1])); w.y = pk_f16(sigmoidf_(v[2] + b0[2]), sigmoidf_(v[3] + b0[3]));
                w.z = pk_f16(sigmoidf_(v[4] + b1[0]), sigmoidf_(v[5] + b1[1])); w.w = pk_f16(sigmoidf_(v[6] + b1[2]), sigmoidf_(v[7] + b1[3]));
                *(u32x4*)(ua + (size_t)row * 4096 + off + gc) = w; } }
    }
};
struct EpiMerge {
    static constexpr bool PERM = true, MID = true;
    const bf16_t* g; bf16_t* merged;
    __device__ __forceinline__ void mid(f32x4 (&acc)[2][2][4][2], const Unit& u, int wr, int wc, int fr, int fq) const {
        int row0 = u.pm * 256 + wr * 64 + fr, cl = u.pn * 256 + wc * 32 + 8 * fq; asm volatile("" : "+v"(row0), "+v"(cl));
#pragma unroll
        for (int ai = 0; ai < 2; ++ai) { u32x4 w1[4][2], w2[4][2];
            __builtin_amdgcn_sched_barrier(0);
#pragma unroll
            for (int m = 0; m < 4; ++m)
#pragma unroll
                for (int bj = 0; bj < 2; ++bj) { const bf16_t* gp = g + (size_t)(row0 + ai * 128 + m * 16) * 4096 + cl + bj * 128; w1[m][bj] = *(const u32x4*)gp; w2[m][bj] = *(const u32x4*)(gp + 2048); }
            __builtin_amdgcn_sched_barrier(0);
#pragma unroll
            for (int m = 0; m < 4; ++m)
#pragma unroll
                for (int bj = 0; bj < 2; ++bj) { float g1[8], g2[8]; unpack8(w1[m][bj], g1); unpack8(w2[m][bj], g2);
#pragma unroll
                    for (int j = 0; j < 4; ++j) { acc[ai][bj][m][0][j] *= g1[j] * __builtin_amdgcn_rcpf(fmaxf(g2[j], 1e-30f)); acc[ai][bj][m][1][j] *= g1[4 + j] * __builtin_amdgcn_rcpf(fmaxf(g2[4 + j], 1e-30f)); } } }
    }
    __device__ __forceinline__ void operator()(AccRef acc, const Unit& u, int wr, int wc, int fr, int fq) const {
        const int row0 = u.pm * 256 + wr * 64 + fr, cl = u.pn * 256 + wc * 32 + 8 * fq;
#pragma unroll
        for (int ai = 0; ai < 2; ++ai) { u32x4 w2[4][2];
            __builtin_amdgcn_sched_barrier(0);
#pragma unroll
            for (int m = 0; m < 4; ++m)
#pragma unroll
                for (int bj = 0; bj < 2; ++bj) w2[m][bj] = *(const u32x4*)(g + (size_t)(row0 + ai * 128 + m * 16) * 4096 + 2048 + cl + bj * 128);
            __builtin_amdgcn_sched_barrier(0);
#pragma unroll
            for (int m = 0; m < 4; ++m) { const int row = row0 + ai * 128 + m * 16;
#pragma unroll
                for (int bj = 0; bj < 2; ++bj) { EPI_GET8(v); const int gc = cl + bj * 128; float g2[8]; unpack8(w2[m][bj], g2);
#pragma unroll
                    for (int j = 0; j < 8; ++j) v[j] *= g2[j];
                    *(u32x4*)(merged + (size_t)row * 2048 + gc) = pack8(v); } } }
    }
};
struct EpiOut {
    static constexpr bool PERM = true, MID = false;
    bf16_t* o;
    __device__ __forceinline__ void operator()(AccRef acc, const Unit& u, int wr, int wc, int fr, int fq) const {
        const int row0 = u.pm * 256 + wr * 64 + fr, cl = u.pn * 256 + wc * 32 + 8 * fq;
        EPI_LOOP_ROWS { __builtin_amdgcn_sched_barrier(0); const int row = row0 + ai * 128 + m * 16;
#pragma unroll
            for (int bj = 0; bj < 2; ++bj) { EPI_GET8(v); *(u32x4*)(o + (size_t)row * 2048 + cl + bj * 128) = pack8(v); } }
    }
};

namespace att {
constexpr int NW = 8, QBLK = 32, KVBLK = 64;
constexpr float SCALE = 0.07216878364870322f;
constexpr float THR = 8.f;
constexpr int LDQ = 1536, LDK = 2048, LDR = 64, LDO = 2048;
constexpr size_t SHM_V = KVBLK * 128 * 2, SHM_K = KVBLK * 128 * 2, SHM_R = KVBLK * 64 * 2;
#define KSWZ(row, colB) ((row) * 256 + ((colB) ^ (((row) & 7) << 4)))
#define RSWZ(row, colB) ((row) * 128 + ((colB) ^ ((((row) >> 1) & 7) << 4)))
#define SBAR() __builtin_amdgcn_sched_barrier(0)
__device__ __forceinline__ int crow(int r, int hi) { return (r & 3) + 8 * (r >> 2) + 4 * hi; }
__device__ __forceinline__ void partialSM(f32x16& p0, f32x16& p1, float& m_reg, float& mn, float& alpha) {
    constexpr float C = SCALE * 1.4426950408889634f;
    float pmax = p0[0];
#pragma unroll
    for (int r = 1; r < 16; ++r) pmax = fmaxf(pmax, p0[r]);
#pragma unroll
    for (int r = 0; r < 16; ++r) pmax = fmaxf(pmax, p1[r]);
    { auto rr = __builtin_amdgcn_permlane32_swap(__float_as_uint(pmax), __float_as_uint(pmax), false, false); pmax = fmaxf(__uint_as_float(rr[0]), __uint_as_float(rr[1])); }
    if (__builtin_expect(__all(pmax - m_reg <= THR / SCALE), 1)) { mn = m_reg; alpha = 1.f; }
    else { mn = fmaxf(m_reg, pmax); alpha = __builtin_amdgcn_exp2f((m_reg - mn) * C); m_reg = mn; }
    const float mnC = -mn * C;
#pragma unroll
    for (int r = 0; r < 16; ++r) p0[r] = fmaf(p0[r], C, mnC);
#pragma unroll
    for (int r = 0; r < 16; ++r) p1[r] = fmaf(p1[r], C, mnC);
#pragma unroll
    for (int r = 0; r < 16; ++r) p0[r] = __builtin_amdgcn_exp2f(p0[r]);
}
__device__ __forceinline__ void finishSM(f32x16& p0, f32x16& p1, float alpha, float& l_reg, bf16x8& pa0, bf16x8& pa1, bf16x8& pa2, bf16x8& pa3) {
#pragma unroll
    for (int r = 0; r < 16; ++r) p1[r] = __builtin_amdgcn_exp2f(p1[r]);
    float ps = 0;
#pragma unroll
    for (int r = 0; r < 16; ++r) ps += p0[r];
#pragma unroll
    for (int r = 0; r < 16; ++r) ps += p1[r];
    { auto rr = __builtin_amdgcn_permlane32_swap(__float_as_uint(ps), __float_as_uint(ps), false, false); ps = __uint_as_float(rr[0]) + __uint_as_float(rr[1]); }
    l_reg = l_reg * alpha + ps;
#define PK4(P, BASE, OUT) do { unsigned a0 = cvt_pk_bf16(P[BASE + 0], P[BASE + 1]), a1 = cvt_pk_bf16(P[BASE + 2], P[BASE + 3]);   \
    unsigned b0 = cvt_pk_bf16(P[BASE + 4], P[BASE + 5]), b1 = cvt_pk_bf16(P[BASE + 6], P[BASE + 7]);                              \
    auto r0 = __builtin_amdgcn_permlane32_swap(a0, b0, false, false); auto r1 = __builtin_amdgcn_permlane32_swap(a1, b1, false, false); \
    u32x4 w = {r0[0], r1[0], r0[1], r1[1]}; OUT = *reinterpret_cast<bf16x8*>(&w); } while (0)
    PK4(p0, 0, pa0); PK4(p0, 8, pa1); PK4(p1, 0, pa2); PK4(p1, 8, pa3);
#undef PK4
}
__device__ __forceinline__ void qkt(f32x16& p0, f32x16& p1, const char* Ks, const char* Rs, const bf16x8* qr, const char* qrl, int r32, int hi) {
    p0 = f32x16{}; p1 = f32x16{};
#pragma unroll
    for (int d0 = 0; d0 < 8; ++d0) { const int cb = (d0 * 16 + hi * 8) * 2;
        const bf16x8 b0 = *reinterpret_cast<const bf16x8*>(Ks + KSWZ(r32, cb));
        const bf16x8 b1 = *reinterpret_cast<const bf16x8*>(Ks + KSWZ(32 + r32, cb));
        const bf16x8 qv = d0 < 6 ? qr[d0] : *reinterpret_cast<const bf16x8*>(qrl + (d0 - 6) * 1024);
        p0 = __builtin_amdgcn_mfma_f32_32x32x16_bf16(b0, qv, p0, 0, 0, 0);
        p1 = __builtin_amdgcn_mfma_f32_32x32x16_bf16(b1, qv, p1, 0, 0, 0); }
#pragma unroll
    for (int d0 = 0; d0 < 4; ++d0) { const int cb = (d0 * 16 + hi * 8) * 2;
        const bf16x8 b0 = *reinterpret_cast<const bf16x8*>(Rs + RSWZ(r32, cb));
        const bf16x8 b1 = *reinterpret_cast<const bf16x8*>(Rs + RSWZ(32 + r32, cb));
        const bf16x8 qv = *reinterpret_cast<const bf16x8*>(qrl + (2 + d0) * 1024);
        p0 = __builtin_amdgcn_mfma_f32_32x32x16_bf16(b0, qv, p0, 0, 0, 0);
        p1 = __builtin_amdgcn_mfma_f32_32x32x16_bf16(b1, qv, p1, 0, 0, 0); }
}
__device__ __forceinline__ int v_st(int k, int c) { const int kk = (k & ~0xC) | ((k & 4) << 1) | ((k & 8) >> 1); return ((kk >> 3) * 4 + (c >> 5)) * 512 + ((kk & 7) * 32 + (c & 31)) * 2; }
__device__ __forceinline__ int v_rd_base(int lane) { return ((lane & 3) << 3) | (((lane >> 2) & 3) << 6) | (((lane >> 4) & 1) << 5) | (((lane >> 5) & 1) << 8); }
constexpr int v_rd_off(int d0, int ks, int half) { return d0 * 512 + ks * 4096 + half * 2048; }
template <int OFF> __device__ __forceinline__ s16x4 tr_read(int vb) { s16x4 r; asm volatile("ds_read_b64_tr_b16 %0, %1 offset:%2" : "=&v"(r) : "v"(vb), "i"(OFF) : "memory"); return r; }
template <int D0> __device__ __forceinline__ void pv_one(f32x16& od, int vb, bf16x8 pa0, bf16x8 pa1, bf16x8 pa2, bf16x8 pa3) {
    const s16x4 l0 = tr_read<v_rd_off(D0, 0, 0)>(vb), h0 = tr_read<v_rd_off(D0, 0, 1)>(vb), l1 = tr_read<v_rd_off(D0, 1, 0)>(vb), h1 = tr_read<v_rd_off(D0, 1, 1)>(vb);
    const s16x4 l2 = tr_read<v_rd_off(D0, 2, 0)>(vb), h2 = tr_read<v_rd_off(D0, 2, 1)>(vb), l3 = tr_read<v_rd_off(D0, 3, 0)>(vb), h3 = tr_read<v_rd_off(D0, 3, 1)>(vb);
    asm volatile("s_waitcnt lgkmcnt(0)" ::: "memory"); SBAR();
#define PK(L, H) (bf16x8){L[0], L[1], L[2], L[3], H[0], H[1], H[2], H[3]}
    od = __builtin_amdgcn_mfma_f32_32x32x16_bf16(pa0, PK(l0, h0), od, 0, 0, 0);
    od = __builtin_amdgcn_mfma_f32_32x32x16_bf16(pa1, PK(l1, h1), od, 0, 0, 0);
    od = __builtin_amdgcn_mfma_f32_32x32x16_bf16(pa2, PK(l2, h2), od, 0, 0, 0);
    od = __builtin_amdgcn_mfma_f32_32x32x16_bf16(pa3, PK(l3, h3), od, 0, 0, 0);
#undef PK
}
__device__ __forceinline__ void pv_d0(f32x16* o, int vb, bf16x8 pa0, bf16x8 pa1, bf16x8 pa2, bf16x8 pa3) {
    pv_one<0>(o[0], vb, pa0, pa1, pa2, pa3); pv_one<1>(o[1], vb, pa0, pa1, pa2, pa3); pv_one<2>(o[2], vb, pa0, pa1, pa2, pa3); pv_one<3>(o[3], vb, pa0, pa1, pa2, pa3);
}
__device__ __forceinline__ void attn_body(const bf16_t* __restrict__ Qb, const bf16_t* __restrict__ Kh, const bf16_t* __restrict__ Vh, const bf16_t* __restrict__ Rh,
                                          bf16_t* __restrict__ Zb, int seq, char* lds, int tid_in) {
    int tid_l = tid_in; asm volatile("" : "+v"(tid_l));
    const int tid = tid_l, wid = tid >> 6, lane = tid & 63, r32 = lane & 31, hi = lane >> 5;
    char* V_lds = lds; char* K_lds = lds + 2 * SHM_V; char* R_lds = lds + 2 * SHM_V + 2 * SHM_K;
    float* wsf = (float*)(lds + 2 * SHM_V + 2 * SHM_K + 2 * SHM_R) + wid * 64; float* li_l = wsf; float* al_l = wsf + 32;
    float m_reg = -1e30f, l_reg = 0; f32x16 o[4] = {}; bf16x8 qr[6];
    char* qrl = lds + 2 * SHM_V + 2 * SHM_K + 2 * SHM_R + 2048 + wid * 6144 + lane * 16;
    const bf16_t* Qw = Qb + (long)(wid * QBLK + r32) * LDQ + hi * 8;
#pragma unroll
    for (int d0 = 0; d0 < 6; ++d0) qr[d0] = *reinterpret_cast<const bf16x8*>(Qw + d0 * 16);
    const int sr = tid >> 4, sc = (tid & 15) * 8, vst0 = v_st(sr, sc), vst1 = v_st(32 + sr, sc);
    const int rr_ = tid >> 3, rc_ = (tid & 7) * 8;
    const int vb0 = (int)(uintptr_t)V_lds + v_rd_base(lane);
    struct { bf16x8 vs0, vs1, ks0, ks1, rs; } sr_[1];
#define SLOAD(i, k0) do { sr_[i].vs0 = *(const bf16x8*)(&Vh[(long)((k0) + sr) * LDK + sc]); sr_[i].vs1 = *(const bf16x8*)(&Vh[(long)((k0) + 32 + sr) * LDK + sc]); \
    sr_[i].ks0 = *(const bf16x8*)(&Kh[(long)((k0) + sr) * LDK + sc]); sr_[i].ks1 = *(const bf16x8*)(&Kh[(long)((k0) + 32 + sr) * LDK + sc]); \
    sr_[i].rs = *(const bf16x8*)(&Rh[(long)((k0) + rr_) * LDR + rc_]); } while (0)
#define SWRITE(b, i) do { *(bf16x8*)(V_lds + (b) * SHM_V + vst0) = sr_[i].vs0; *(bf16x8*)(V_lds + (b) * SHM_V + vst1) = sr_[i].vs1; const int kc = sc * 2;  \
    *(bf16x8*)(K_lds + (b) * SHM_K + KSWZ(sr, kc)) = sr_[i].ks0; *(bf16x8*)(K_lds + (b) * SHM_K + KSWZ(32 + sr, kc)) = sr_[i].ks1; \
    *(bf16x8*)(R_lds + (b) * SHM_R + RSWZ(rr_, rc_ * 2)) = sr_[i].rs; } while (0)
#define SWAIT() asm volatile("s_waitcnt vmcnt(0)" ::: "memory")
#define RESC(a) do { if (__any((a) < 1.f)) { if (hi == 0) al_l[r32] = (a); asm volatile("s_waitcnt lgkmcnt(0)" ::: "memory"); \
    _Pragma("unroll") for (int d = 0; d < 4; ++d) _Pragma("unroll") for (int r = 0; r < 16; ++r) o[d][r] *= al_l[crow(r, hi)]; } } while (0)
    f32x16 pA0, pA1, pB0, pB1; float mnA, mnB, alA, alB; bf16x8 pa0, pa1, pa2, pa3; const int NT = seq / KVBLK;
    __syncthreads();
#pragma unroll
    for (int d0 = 0; d0 < 6; ++d0) *reinterpret_cast<bf16x8*>(qrl + d0 * 1024) = *reinterpret_cast<const bf16x8*>(Qw + 96 + d0 * 16);
    SLOAD(0, 0); asm volatile("s_waitcnt vmcnt(0)" ::: "memory"); SWRITE(0, 0); __syncthreads();
    qkt(pA0, pA1, K_lds, R_lds, qr, qrl, r32, hi); partialSM(pA0, pA1, m_reg, mnA, alA);
    SLOAD(0, KVBLK);
    SWAIT(); SWRITE(1, 0); __syncthreads();
    for (int j = 1; j + 1 < NT; j += 2) {
        SBAR(); qkt(pB0, pB1, K_lds + SHM_K, R_lds + SHM_R, qr, qrl, r32, hi);
        finishSM(pA0, pA1, alA, l_reg, pa0, pa1, pa2, pa3); SBAR();
        SLOAD(0, (j + 1) * KVBLK); SBAR();
        pv_d0(o, vb0, pa0, pa1, pa2, pa3); partialSM(pB0, pB1, m_reg, mnB, alB);
        __syncthreads(); SWAIT(); SWRITE(0, 0);
        RESC(alB); __syncthreads();
        SBAR(); qkt(pA0, pA1, K_lds, R_lds, qr, qrl, r32, hi);
        finishSM(pB0, pB1, alB, l_reg, pa0, pa1, pa2, pa3); SBAR();
        SLOAD(0, (j + 2) * KVBLK); SBAR();
        pv_d0(o, vb0 + (int)SHM_V, pa0, pa1, pa2, pa3); partialSM(pA0, pA1, m_reg, mnA, alA);
        __syncthreads(); SWAIT(); SWRITE(1, 0);
        RESC(alA); __syncthreads();
    }
    SBAR(); qkt(pB0, pB1, K_lds + SHM_K, R_lds + SHM_R, qr, qrl, r32, hi);
    finishSM(pA0, pA1, alA, l_reg, pa0, pa1, pa2, pa3); SBAR();
    pv_d0(o, vb0, pa0, pa1, pa2, pa3); partialSM(pB0, pB1, m_reg, mnB, alB);
    __syncthreads(); RESC(alB);
    finishSM(pB0, pB1, alB, l_reg, pa0, pa1, pa2, pa3); SBAR();
    pv_d0(o, vb0 + (int)SHM_V, pa0, pa1, pa2, pa3);
    if (hi == 0) li_l[r32] = l_reg;
    __syncthreads();
    { constexpr int SP = 272;
      char* stg = lds + wid * (32 * SP);
#pragma unroll
      for (int r = 0; r < 16; ++r) { const int orow = crow(r, hi); const float rli = __builtin_amdgcn_rcpf(li_l[orow]);
#pragma unroll
          for (int d0 = 0; d0 < 4; ++d0) *(bf16_t*)(stg + orow * SP + (d0 * 32 + r32) * 2) = f2bf(o[d0][r] * rli); }
      asm volatile("s_waitcnt lgkmcnt(0)" ::: "memory");
      bf16_t* Zw = Zb + (long)(wid * QBLK) * LDO;
      u32x4 zw[8];
#pragma unroll
      for (int i = 0; i < 8; ++i) { const int c = i * 64 + lane; zw[i] = *(const u32x4*)(Zw + (long)(c >> 4) * LDO + (c & 15) * 8); }
#pragma unroll
      for (int i = 0; i < 8; ++i) { const int c = i * 64 + lane, row = c >> 4, col8 = (c & 15) * 8;
          float ov[8], zv[8]; unpack8(*(const u32x4*)(stg + row * SP + col8 * 2), ov); unpack8(zw[i], zv);
#pragma unroll
          for (int e = 0; e < 8; ++e) ov[e] *= zv[e];
          *(u32x4*)(Zw + (long)row * LDO + col8) = pack8(ov); } }
#undef SLOAD
#undef SWRITE
#undef SWAIT
#undef RESC
}
}

__device__ __forceinline__ int map_col(int mode, int n) {
    if (mode == 1) {
        if (n < 1024) return n;
        if (n < 1536) { const int m = n - 1024; if (m < 64) return 1024 + (m >> 1) + 32 * (m & 1); if (m < 448) return 4096 + m; return -1; }
        if (n < 4608) return 1088 + (n - 1536);
        return n - 64;
    }
    if (mode == 2) { const int h = n / 192, c = n % 192; if (c < 128) return n; const int m = c - 128; return h * 192 + 128 + (m >> 1) + 32 * (m & 1); }
    return n;
}
__device__ __forceinline__ void transpose_tile(const float* src, int lds_, int K, bf16_t* dst, int mode, const float* scale, int tile, float* tl, int tid, int ldd = 0) {
    if (ldd == 0) ldd = K;
    const int nkb = K / 64, nb = tile / nkb, kb = tile % nkb, n0 = nb * 64, k0 = kb * 64;
    const int s0 = map_col(mode, n0), s63 = map_col(mode, n0 + 63);
    __syncthreads();
    if ((s0 >= 0 && s63 == s0 + 63 && map_col(mode, n0 + 1) == s0 + 1) || (s0 < 0 && s63 < 0)) {
        const int n4 = (tid & 15) * 4;
#pragma unroll
        for (int it = 0; it < 2; ++it) { const int kk = (tid >> 4) + 32 * it; f32x4 v = s0 >= 0 ? *(const f32x4*)(src + (size_t)(k0 + kk) * lds_ + s0 + n4) : (f32x4){0.f, 0.f, 0.f, 0.f};
            if (scale) v = v * scale[k0 + kk];
            tl[kk * 65 + n4 + 0] = v[0]; tl[kk * 65 + n4 + 1] = v[1]; tl[kk * 65 + n4 + 2] = v[2]; tl[kk * 65 + n4 + 3] = v[3]; }
    } else {
        const int nn = tid & 63, sc = map_col(mode, n0 + nn);
#pragma unroll
        for (int it = 0; it < 8; ++it) { const int kk = (tid >> 6) + 8 * it; float v = sc >= 0 ? src[(size_t)(k0 + kk) * lds_ + sc] : 0.f; if (scale) v *= scale[k0 + kk]; tl[kk * 65 + nn] = v; }
    }
    __syncthreads();
    const int nr = tid >> 3, kc = (tid & 7) * 8; float v[8];
#pragma unroll
    for (int e = 0; e < 8; ++e) v[e] = tl[(kc + e) * 65 + nr];
    *(u32x4*)(dst + (size_t)(n0 + nr) * ldd + k0 + kc) = pack8(v);
}

constexpr int SC_C = 32;
struct ScanOps { f32x4 w0, w1, a0, a1, b0, b1, k0, k1, r0, r1; float v; };
__device__ __forceinline__ void scan_chain(const Params& p, int c, char* lds, int tid_in) {
    const bf16_t* rkv = (const bf16_t*)(p.ws + WS_RKV); const unsigned short* ua = (const unsigned short*)(p.ws + WS_UA);
    const int dir = c >> 7, b = (c >> 4) & 7, h = c & 15;
    float* yout = (float*)(p.ws + (dir ? WS_YB : WS_YF));
    int tid_l = tid_in; asm volatile("" : "+v"(tid_l));
    const int tid = tid_l, wid = tid >> 6, lane = tid & 63, row = tid >> 3, sub = tid & 7;
    float* L = (float*)lds;
    float* ybuf = L + 2 * 6 * SC_C * 64;
    const int psl = tid >> 4, pc4 = (tid & 15) * 4, ch = h * 64 + pc4;
    const f32x4 mu_r = *(const f32x4*)(p.mu + ch), mu_k = *(const f32x4*)(p.mu + 1024 + ch), mu_v = *(const f32x4*)(p.mu + 2048 + ch), kk_c = *(const f32x4*)(p.k_k + ch), ka_c = *(const f32x4*)(p.k_a + ch);
    f32x2 s01 = {0.f, 0.f}, s23 = {0.f, 0.f}, s45 = {0.f, 0.f}, s67 = {0.f, 0.f};
    u32x2 raw[3][3], raw_u, raw_a;
    const size_t tok0 = (size_t)b * SEQ;
#define SC_LOAD(chunk) do { const int st = (chunk) * SC_C + psl; const int t = dir ? (SEQ - 1 - st) : st; \
        const bf16_t* base = rkv + (tok0 + t) * 3072 + ch; const bool hm = t > 0, hp = t < SEQ - 1; \
        _Pragma("unroll") for (int sg = 0; sg < 3; ++sg) { raw[sg][1] = *(const u32x2*)(base + sg * 1024); \
            raw[sg][0] = hm ? *(const u32x2*)(base + sg * 1024 - 3072) : (u32x2){0u, 0u}; raw[sg][2] = hp ? *(const u32x2*)(base + sg * 1024 + 3072) : (u32x2){0u, 0u}; } \
        const unsigned short* ub = ua + (tok0 + t) * 4096 + dir * 1024 + ch; raw_u = *(const u32x2*)ub; raw_a = *(const u32x2*)(ub + 2048); } while (0)
#define SC_PREP(bufi) do { float* Lb = L + (bufi) * 6 * SC_C * 64 + psl * 64 + pc4; float rr[3][3][4]; \
        _Pragma("unroll") for (int sg = 0; sg < 3; ++sg) _Pragma("unroll") for (int d = 0; d < 3; ++d) unpack4(raw[sg][d], rr[sg][d]); \
        float uu[4], aa[4]; unpack4h(raw_u, uu); unpack4h(raw_a, aa); f32x4 r4, k4, v4, kk4; float n2 = 0.f; \
        _Pragma("unroll") for (int e = 0; e < 4; ++e) { r4[e] = rr[0][1][e] + mu_r[e] * (0.5f * (rr[0][0][e] + rr[0][2][e]) - rr[0][1][e]); k4[e] = rr[1][1][e] + mu_k[e] * (0.5f * (rr[1][0][e] + rr[1][2][e]) - rr[1][1][e]); \
            v4[e] = rr[2][1][e] + mu_v[e] * (0.5f * (rr[2][0][e] + rr[2][2][e]) - rr[2][1][e]); kk4[e] = k4[e] * kk_c[e]; n2 += kk4[e] * kk4[e]; } \
        const float rn = __builtin_amdgcn_rsqf(fmaxf(red16(n2), 1e-24f)); f32x4 w4, na4, b4, kf4; \
        _Pragma("unroll") for (int e = 0; e < 4; ++e) { const float kk = kk4[e] * rn; w4[e] = __expf(-0.6065306597126334f * uu[e]); na4[e] = -kk; b4[e] = kk * aa[e]; kf4[e] = k4[e] * (1.f + (aa[e] - 1.f) * ka_c[e]); } \
        *(f32x4*)(Lb + 0 * SC_C * 64) = w4; *(f32x4*)(Lb + 1 * SC_C * 64) = na4; *(f32x4*)(Lb + 2 * SC_C * 64) = b4; *(f32x4*)(Lb + 3 * SC_C * 64) = kf4; *(f32x4*)(Lb + 4 * SC_C * 64) = r4; *(f32x4*)(Lb + 5 * SC_C * 64) = v4; } while (0)
#define SC_FLUSH(chunk) do { const float* yb = ybuf + ((chunk) & 1) * SC_C * 64; const int sl = tid >> 4, i4 = (tid & 15) * 4; const int st = (chunk) * SC_C + sl; const int t = dir ? (SEQ - 1 - st) : st; \
        *(f32x4*)(yout + (tok0 + t) * 1024 + h * 64 + i4) = *(const f32x4*)(yb + sl * 64 + i4); } while (0)
    constexpr int NCH = SEQ / SC_C;
    __syncthreads();
    SC_LOAD(0); SC_PREP(0); __syncthreads();
    for (int n = 0; n < NCH; ++n) {
        if (n + 1 < NCH) SC_LOAD(n + 1);
        if (n > 0) SC_FLUSH(n - 1);
        const float* Lb = L + (n & 1) * 6 * SC_C * 64 + sub * 8; float* yb = ybuf + (n & 1) * SC_C * 64;
        const float* Lv = L + (n & 1) * 6 * SC_C * 64 + 5 * SC_C * 64 + row;
#define SC_LDA(O, sl) do { O.w0 = *(const f32x4*)(Lb + (0 * SC_C + (sl)) * 64); O.w1 = *(const f32x4*)(Lb + (0 * SC_C + (sl)) * 64 + 4); O.a0 = *(const f32x4*)(Lb + (1 * SC_C + (sl)) * 64); O.a1 = *(const f32x4*)(Lb + (1 * SC_C + (sl)) * 64 + 4); \
        O.b0 = *(const f32x4*)(Lb + (2 * SC_C + (sl)) * 64); O.b1 = *(const f32x4*)(Lb + (2 * SC_C + (sl)) * 64 + 4); } while (0)
#define SC_LDB(O, sl) do { O.k0 = *(const f32x4*)(Lb + (3 * SC_C + (sl)) * 64); O.k1 = *(const f32x4*)(Lb + (3 * SC_C + (sl)) * 64 + 4); \
        O.r0 = *(const f32x4*)(Lb + (4 * SC_C + (sl)) * 64); O.r1 = *(const f32x4*)(Lb + (4 * SC_C + (sl)) * 64 + 4); O.v = Lv[(sl) * 64]; } while (0)
#define SC_LD(O, sl) do { SC_LDA(O, sl); SC_LDB(O, sl); } while (0)
#define LO2(x) __builtin_shufflevector(x, x, 0, 1)
#define HI2(x) __builtin_shufflevector(x, x, 2, 3)
        ScanOps o0, o1, o2; SC_LD(o0, 0); SC_LD(o1, 1);
        float ysel = 0.f, ypend = 0.f;
#define SC_STEP(cur, ld, u) do { \
            f32x2 acc = s01 * LO2(cur.a0); acc = __builtin_elementwise_fma(s23, HI2(cur.a0), acc); acc = __builtin_elementwise_fma(s45, LO2(cur.a1), acc); acc = __builtin_elementwise_fma(s67, HI2(cur.a1), acc); \
            float t_ = acc.x + acc.y; \
            t_ += dppx<0xB1>(t_); ypend += dppx<0xB1>(ypend); t_ += dppx<0x4E>(t_); ypend += dppx<0x4E>(ypend); t_ += dppx<0x141>(t_); ypend += dppx<0x141>(ypend); \
            const float sa = t_; \
            if ((u) > 0) { ysel = (sub == (((u) - 1) & 7)) ? ypend : ysel; if ((((u) - 1) & 7) == 7) yb[((u) - 8 + sub) * 64 + row] = ysel; } \
            __builtin_amdgcn_sched_barrier(0); if ((u) + 2 < SC_C) SC_LDA(ld, (u) + 2); __builtin_amdgcn_sched_barrier(0); \
            const f32x2 sa2 = {sa, sa}, vi2 = {cur.v, cur.v}; \
            s01 = __builtin_elementwise_fma(LO2(cur.k0), vi2, __builtin_elementwise_fma(LO2(cur.b0), sa2, s01 * LO2(cur.w0))); \
            s23 = __builtin_elementwise_fma(HI2(cur.k0), vi2, __builtin_elementwise_fma(HI2(cur.b0), sa2, s23 * HI2(cur.w0))); \
            s45 = __builtin_elementwise_fma(LO2(cur.k1), vi2, __builtin_elementwise_fma(LO2(cur.b1), sa2, s45 * LO2(cur.w1))); \
            s67 = __builtin_elementwise_fma(HI2(cur.k1), vi2, __builtin_elementwise_fma(HI2(cur.b1), sa2, s67 * HI2(cur.w1))); \
            __builtin_amdgcn_sched_barrier(0); if ((u) + 2 < SC_C) SC_LDB(ld, (u) + 2); __builtin_amdgcn_sched_barrier(0); \
            f32x2 yy = s01 * LO2(cur.r0); yy = __builtin_elementwise_fma(s23, HI2(cur.r0), yy); yy = __builtin_elementwise_fma(s45, LO2(cur.r1), yy); yy = __builtin_elementwise_fma(s67, HI2(cur.r1), yy); \
            ypend = yy.x + yy.y;     \
            __builtin_amdgcn_sched_barrier(0); } while (0)
#define SC_STEP3(u) SC_STEP(o0, o2, u); SC_STEP(o1, o0, (u) + 1); SC_STEP(o2, o1, (u) + 2)
        SC_STEP3(0); SC_STEP3(3); SC_STEP3(6); SC_STEP3(9); SC_STEP3(12); SC_STEP3(15); SC_STEP3(18); SC_STEP3(21); SC_STEP3(24); SC_STEP3(27);
        SC_STEP(o0, o2, 30); SC_STEP(o1, o0, 31);
        { const float yl = red8(ypend); ysel = (sub == 7) ? yl : ysel; yb[(24 + sub) * 64 + row] = ysel; }
#undef SC_STEP3
#undef SC_STEP
#undef SC_LD
#undef SC_LDA
#undef SC_LDB
#undef LO2
#undef HI2
        if (n + 1 < NCH) SC_PREP((n + 1) & 1);
        __syncthreads();
    }
    SC_FLUSH(NCH - 1);
#undef SC_LOAD
#undef SC_PREP
#undef SC_FLUSH
}

struct P5In { f32x4 yf[2], yb[2]; u32x4 r[3][3]; u32x4 af, ab, z; };
__device__ __forceinline__ void unpack8h(u32x4 w, float* v) { v[0] = h2f((unsigned short)(w.x & 0xffffu)); v[1] = h2f((unsigned short)(w.x >> 16)); v[2] = h2f((unsigned short)(w.y & 0xffffu)); v[3] = h2f((unsigned short)(w.y >> 16));
    v[4] = h2f((unsigned short)(w.z & 0xffffu)); v[5] = h2f((unsigned short)(w.z >> 16)); v[6] = h2f((unsigned short)(w.w & 0xffffu)); v[7] = h2f((unsigned short)(w.w >> 16)); }
__device__ __forceinline__ void p5_load(P5In& in, int it, int c8, const float* __restrict__ yf, const float* __restrict__ yb, const bf16_t* __restrict__ rkv, const unsigned short* __restrict__ ua, const bf16_t* zb) {
    const int row = it >> 1, ch = (it & 1) * 512 + c8, t = row & (SEQ - 1);
    const float* yfp = yf + (size_t)row * 1024 + ch; const float* ybp = yb + (size_t)row * 1024 + ch;
    in.yf[0] = *(const f32x4*)yfp; in.yf[1] = *(const f32x4*)(yfp + 4); in.yb[0] = *(const f32x4*)ybp; in.yb[1] = *(const f32x4*)(ybp + 4);
    const bf16_t* base = rkv + (size_t)row * 3072 + ch; const bool hm = t > 0, hp = t < SEQ - 1;
#pragma unroll
    for (int sg = 0; sg < 3; ++sg) { in.r[sg][1] = *(const u32x4*)(base + sg * 1024);
        in.r[sg][0] = hm ? *(const u32x4*)(base + sg * 1024 - 3072) : (u32x4){0u, 0u, 0u, 0u}; in.r[sg][2] = hp ? *(const u32x4*)(base + sg * 1024 + 3072) : (u32x4){0u, 0u, 0u, 0u}; }
    const unsigned short* ub = ua + (size_t)row * 4096 + 2048 + ch; in.af = *(const u32x4*)ub; in.ab = *(const u32x4*)(ub + 1024);
    in.z = *(const u32x4*)(zb + (size_t)row * 2048 + 1024 + ch);
}
struct P5Par { float mur[8], muk[8], muv[8], ka[8], rk[8], gg[8], gb[8]; };
__device__ __forceinline__ void p5_finish(const P5In& in, int it, int c8, const P5Par& pp, bf16_t* zb) {
    const int row = it >> 1, ch = (it & 1) * 512 + c8;
    float y[8], sy = 0.f;
#pragma unroll
    for (int e = 0; e < 8; ++e) { y[e] = in.yf[e >> 2][e & 3] + in.yb[e >> 2][e & 3]; sy += y[e]; }
    const float mean = red8(sy) * (1.f / 64.f); float sv = 0.f;
#pragma unroll
    for (int e = 0; e < 8; ++e) { y[e] -= mean; sv += y[e] * y[e]; }
    const float rstd = rsqrtf(red8(sv) * (1.f / 64.f) + 64e-5f);
    float rr[3][3][8];
#pragma unroll
    for (int sg = 0; sg < 3; ++sg)
#pragma unroll
        for (int d = 0; d < 3; ++d) unpack8(in.r[sg][d], rr[sg][d]);
    float af[8], ab[8], zz[8], vv[8], sb = 0.f; unpack8h(in.af, af); unpack8h(in.ab, ab); unpack8(in.z, zz);
#pragma unroll
    for (int e = 0; e < 8; ++e) { const float r = rr[0][1][e] + pp.mur[e] * (0.5f * (rr[0][0][e] + rr[0][2][e]) - rr[0][1][e]), k = rr[1][1][e] + pp.muk[e] * (0.5f * (rr[1][0][e] + rr[1][2][e]) - rr[1][1][e]);
        vv[e] = rr[2][1][e] + pp.muv[e] * (0.5f * (rr[2][0][e] + rr[2][2][e]) - rr[2][1][e]);
        sb += r * (k * (2.f + (af[e] + ab[e] - 2.f) * pp.ka[e])) * pp.rk[e]; }
    const float bon = red8(sb);
    float o[8];
#pragma unroll
    for (int e = 0; e < 8; ++e) o[e] = (y[e] * rstd * pp.gg[e] + pp.gb[e] + bon * vv[e]) * zz[e];
    *(u32x4*)(zb + (size_t)row * 2048 + 1024 + ch) = pack8(o);
}

constexpr int T_IN = (NP1 / 64) * 32, T_Q = 24 * 8, T_KV = 32 * 8, T_BM = 32 * 16, T_OUT = 32 * 32, T_REST = T_Q + T_KV + 2 * T_BM + T_OUT;
constexpr int LDS_PHASE_BYTES = 139264;
#define XB_TMO      128
#define XB_XCNT(j)  (256  + 64 * (j))
#define XB_XSUB(j)  (1280 + 64 * (j))
#define XB_XGEN(j)  (2304 + 64 * (j))
#define XB_TOP      3328
#define XB_TOPGEN   3392
#define XCD_BAR_WORDS 3456
#define XB_SPIN_CAP (1u << 20)
__device__ __forceinline__ unsigned xb_ld(unsigned* p)              { return __hip_atomic_load(p, __ATOMIC_RELAXED, __HIP_MEMORY_SCOPE_AGENT); }
__device__ __forceinline__ unsigned xb_add(unsigned* p, unsigned v) { return __hip_atomic_fetch_add(p, v, __ATOMIC_RELAXED, __HIP_MEMORY_SCOPE_AGENT); }
__device__ __forceinline__ unsigned xb_xcc_id() { return (unsigned)__builtin_amdgcn_s_getreg((3 << 11) | 20) & 0xFu; }
#define XB_SPIN(cond, bar) do { unsigned _sp = 0; while (cond) { __builtin_amdgcn_s_sleep(1); \
    if ((++_sp & 255u) == 0u) { if (xb_ld(&(bar)[XB_TMO])) break; if (_sp > XB_SPIN_CAP) { atomicAdd(&(bar)[XB_TMO], 1u); break; } } } } while (0)
__device__ __forceinline__ void xcd_barrier_complete(unsigned* bar, unsigned x, unsigned G, unsigned& nloc, unsigned& nx) {
    unsigned sum, cnt, mine, sp = 0u;
    for (;;) {
        sum = 0u; cnt = 0u; mine = 0u;
#pragma unroll
        for (unsigned j = 0; j < 16; ++j) { const unsigned c = xb_ld(&bar[XB_XCNT(j)]); sum += c; cnt += (c > 0u) ? 1u : 0u; mine = (j == x) ? c : mine; }
        if (sum == G) break;
        __builtin_amdgcn_s_sleep(1);
        if ((++sp & 255u) == 0u) { if (xb_ld(&bar[XB_TMO])) break; if (sp > XB_SPIN_CAP) { atomicAdd(&bar[XB_TMO], 1u); break; } }
    }
    nloc = mine > 0u ? mine : 1u; nx = cnt > 0u ? cnt : 1u;
}
__device__ __forceinline__ void grid_barrier(unsigned* bar, volatile __attribute__((address_space(3))) unsigned* st, unsigned G, int tid) {
    asm volatile("s_waitcnt vmcnt(0)" ::: "memory");
    __syncthreads();
    if (tid == 0) {
        __builtin_amdgcn_s_waitcnt(0);
        const unsigned x = xb_xcc_id();
        unsigned nloc = st[0], nx = st[1];
        if (nloc == 0u) { xcd_barrier_complete(bar, x, G, nloc, nx); st[0] = nloc; st[1] = nx; }
        const unsigned old = xb_add(&bar[XB_XSUB(x)], 1u);
        const unsigned gen = old / nloc;
        if (old + 1u == (gen + 1u) * nloc) {
            __builtin_amdgcn_fence(__ATOMIC_RELEASE, "agent");
            asm volatile("s_waitcnt vmcnt(0)" ::: "memory");
            const unsigned og = xb_add(&bar[XB_TOP], 1u);
            const unsigned tg = og / nx;
            if (og + 1u == (tg + 1u) * nx) xb_add(&bar[XB_TOPGEN], 1u);
            else XB_SPIN(xb_ld(&bar[XB_TOPGEN]) == tg, bar);
            __builtin_amdgcn_fence(__ATOMIC_ACQUIRE, "agent");
            xb_add(&bar[XB_XGEN(x)], 1u);
            asm volatile("s_waitcnt vmcnt(0)" ::: "memory");
        } else {
            XB_SPIN(xb_ld(&bar[XB_XGEN(x)]) == gen, bar);
            __builtin_amdgcn_fence(__ATOMIC_ACQUIRE, "agent");
            asm volatile("s_waitcnt vmcnt(0)" ::: "memory");
        }
    }
    __syncthreads();
}
typedef const __attribute__((address_space(4))) Params* KP;
__device__ __forceinline__ Params load_params(KP kp) {
#if defined(__HIP_DEVICE_COMPILE__)
    return *kp;
#else
    return Params{};
#endif
}
#define PH_HEADER() \
        KP kp = (KP)__builtin_amdgcn_kernarg_segment_ptr(); asm volatile("" : "+s"(kp)); Params p = load_params(kp); \
         \
        unsigned char* ws = p.ws; asm volatile("" : "+s"(ws)); int tid = wid_s * 64 + (int)__builtin_amdgcn_mbcnt_hi(~0u, __builtin_amdgcn_mbcnt_lo(~0u, 0u)); asm volatile("" : "+v"(tid)); \
        const int wid = tid >> 6, lane = tid & 63, gw = bid * 8 + wid, NGW = G * 8; \
        bf16_t* W_in = (bf16_t*)(ws + WS_WIN); bf16_t* W_q = (bf16_t*)(ws + WS_WQ); bf16_t* W_kv = (bf16_t*)(ws + WS_WKV); bf16_t* W_lw = (bf16_t*)(ws + WS_LW); bf16_t* W_la = (bf16_t*)(ws + WS_LA); \
        bf16_t* W_bm = (bf16_t*)(ws + WS_WBM); bf16_t* W_br = (bf16_t*)(ws + WS_WBR); bf16_t* W_out = (bf16_t*)(ws + WS_WOUT); \
        float* cs = (float*)(ws + WS_CS); float* ssq = (float*)(ws + WS_SSQ); \
        bf16_t* hbuf = (bf16_t*)(ws + WS_H); bf16_t* qa = (bf16_t*)(ws + WS_QA); bf16_t* kva = (bf16_t*)(ws + WS_KVA); bf16_t* misc = (bf16_t*)(ws + WS_MISC); bf16_t* krope = (bf16_t*)(ws + WS_KROPE); \
        bf16_t* rkv = (bf16_t*)(ws + WS_RKV); bf16_t* zb = (bf16_t*)(ws + WS_Z); bf16_t* gb = (bf16_t*)p.out; bf16_t* qb = (bf16_t*)(ws + WS_Q); bf16_t* kvb = (bf16_t*)(ws + WS_KV); \
        bf16_t* Aw = (bf16_t*)(ws + WS_AW); bf16_t* Aa = (bf16_t*)(ws + WS_AA); unsigned short* ua = (unsigned short*)(ws + WS_UA); \
        float* tmp = (float*)(ws + WS_TMP); bf16_t* merged = (bf16_t*)(ws + WS_MERGED); \
        PG8_LAS unsigned char* glds = (PG8_LAS unsigned char*)shm; \
        pg8::StaticOrder S;
__global__ void __launch_bounds__(512) hybrid_fwd(Params p_arg) {
    extern __shared__ __attribute__((aligned(16))) char shm[];
    cg::grid_group grid = cg::this_grid();
    const int G = gridDim.x, bid = blockIdx.x;
    const int wid_s = __builtin_amdgcn_readfirstlane((int)threadIdx.x >> 6);
    const int ph_lo = p_arg.ph_lo, ph_hi = p_arg.ph_hi;
    volatile __attribute__((address_space(3))) unsigned* xb_st = (volatile __attribute__((address_space(3))) unsigned*)(shm + LDS_PHASE_BYTES);
    if (ph_hi - ph_lo > 1) {
        if (threadIdx.x == 0) { xb_st[0] = 0u; xb_st[1] = 0u; (void)xb_add((unsigned*)(p_arg.ws + WS_BAR) + XB_XCNT(xb_xcc_id()), 1u); }
        grid.sync();
    }
        if (PHEN(0) && ph_lo <= 0 && 0 < ph_hi) { PH_HEADER();
        for (int rep_ = 0; rep_ < DBLN(0); ++rep_) {
            for (int it = bid; it < T_IN; it += G) transpose_tile(p.w_in, DIN, 2048, W_in, 1, nullptr, it, (float*)shm, tid);
            for (int i = bid * 512 + tid; i < SEQ * 32; i += G * 512) { const int pos = i >> 5, fi = i & 31; const float inv = exp2f(-(float)fi * (13.287712379549449f / 32.f)); const float ang = (float)pos * inv;
                double rev = (double)ang * 0.15915494309189535; rev -= floor(rev); const float rf = (float)rev;
                cs[2 * i] = __builtin_amdgcn_cosf(rf); cs[2 * i + 1] = __builtin_amdgcn_sinf(rf); }
            f32x4 gpre[4][2];
#pragma unroll
            for (int j = 0; j < 4; ++j)
#pragma unroll
                for (int hh = 0; hh < 2; ++hh) gpre[j][hh] = *(const f32x4*)(p.g_pre + (j * 64 + lane) * 8 + hh * 4);
            for (int row = gw; row < T; row += NGW) { const float* xr = p.x + (size_t)row * DM; f32x4 v[4][2]; float s = 0.f;
#pragma unroll
                for (int j = 0; j < 4; ++j)
#pragma unroll
                    for (int hh = 0; hh < 2; ++hh) { v[j][hh] = *(const f32x4*)(xr + (j * 64 + lane) * 8 + hh * 4); s += (v[j][hh][0] * v[j][hh][0] + v[j][hh][1] * v[j][hh][1]) + (v[j][hh][2] * v[j][hh][2] + v[j][hh][3] * v[j][hh][3]); }
                const float rs = rsqrtf(wave_sum_fast(s) * (1.f / DM) + 1e-6f);
#pragma unroll
                for (int j = 0; j < 4; ++j) { float o[8];
#pragma unroll
                    for (int e = 0; e < 4; ++e) { o[e] = v[j][0][e] * rs * gpre[j][0][e]; o[4 + e] = v[j][1][e] * rs * gpre[j][1][e]; }
                    *(u32x4*)(hbuf + (size_t)row * DM + (j * 64 + lane) * 8) = pack8(o); } }

        } }
        if (PHEN(1) && ph_lo <= 1 && 1 < ph_hi) { PH_HEADER(); if (1 > ph_lo) grid_barrier((unsigned*)(ws + WS_BAR), xb_st, (unsigned)G, tid);
        for (int rep_ = 0; rep_ < DBLN(1); ++rep_) {
            S.init(T, NP1, G, bid); Epi1 E{qa, kva, misc, krope, rkv, zb, gb, ssq, cs};
            pg8::gemm_phase(glds, pg8::Gemm{hbuf, W_in, T, NP1, 2048, 2048, 2048}, S, E, tid);
            if (bid >= G / 2) for (int it = bid - G / 2; it < T_REST; it += G - G / 2) { int r = it; float* tl = (float*)shm;
                if (r < T_Q) { transpose_tile(p.wq_b, 1536, 512, W_q, 2, p.q_norm, r, tl, tid); continue; } r -= T_Q;
                if (r < T_KV) { transpose_tile(p.wkv_b, 2048, 512, W_kv, 0, p.kv_norm, r, tl, tid); continue; } r -= T_KV;
                if (r < T_BM) { transpose_tile(p.w_br_mla, 2048, 1024, W_bm, 0, nullptr, r, tl, tid, 2048); continue; } r -= T_BM;
                if (r < T_BM) { transpose_tile(p.w_br_rwkv, 2048, 1024, W_bm + 1024, 0, nullptr, r, tl, tid, 2048); continue; } r -= T_BM;
                transpose_tile(p.w_out, 2048, 2048, W_out, 0, nullptr, r, tl, tid); }
            if (bid >= G / 2) {
            for (int i = (bid - G / 2) * 512 + tid; i < 2 * 2048 * 32; i += (G - G / 2) * 512) { const int which = i >> 16, rem = i & 65535, kg = rem >> 11, n = rem & 2047, k0 = kg * 8;
                float v[8] = {0.f, 0.f, 0.f, 0.f, 0.f, 0.f, 0.f, 0.f}; const float* sp = nullptr;
                if (n < 1024) { if (k0 < 96) sp = (which ? p.a2_f : p.w2_f) + (size_t)k0 * 1024 + n; } else { if (k0 >= 128 && k0 < 224) sp = (which ? p.a2_b : p.w2_b) + (size_t)(k0 - 128) * 1024 + (n - 1024); }
                if (sp) {
#pragma unroll
                    for (int e = 0; e < 8; ++e) v[e] = sp[(size_t)e * 1024]; }
                *(u32x4*)((which ? W_la : W_lw) + (size_t)n * 256 + k0) = pack8(v); }
            }

        } }
        if (PHEN(2) && ph_lo <= 2 && 2 < ph_hi) { PH_HEADER(); if (2 > ph_lo) grid_barrier((unsigned*)(ws + WS_BAR), xb_st, (unsigned)G, tid);
        for (int rep_ = 0; rep_ < DBLN(2); ++rep_) {
            { S.init(T, 1536, G, bid); EpiQ E{qb, ssq, cs}; pg8::gemm_phase(glds, pg8::Gemm{qa, W_q, T, 1536, 512, 512, 512}, S, E, tid); }
            { S.init(T, 2048, G, bid); EpiKV E{kvb, ssq}; pg8::gemm_phase(glds, pg8::Gemm{kva, W_kv, T, 2048, 512, 512, 512}, S, E, tid); }
            { const int c = tid & 63, isA = c >> 5, cc = (c & 31) * 8, half = cc >> 7, kc = cc & 127;
              const bool live = kc < 96; const int mcol = 64 + isA * 192 + half * 96 + kc;
              float mu8[8];
#pragma unroll
              for (int e = 0; e < 8; ++e) mu8[e] = live ? p.mu[3072 + isA * 192 + half * 96 + kc + e] : 0.f;
              bf16_t* dstb = (isA ? Aa : Aw) + cc;
              for (int row = bid * 8 + (tid >> 6); row < T; row += G * 8) { const int t = row & (SEQ - 1); u32x4 outv = {0u, 0u, 0u, 0u};
                  if (live) { const bf16_t* mp = misc + (size_t)row * 512 + mcol; float o[8], x0[8], xm[8], xp[8];
                      unpack8(*(const u32x4*)mp, x0); unpack8(t > 0 ? *(const u32x4*)(mp - 512) : (u32x4){0u, 0u, 0u, 0u}, xm); unpack8(t < SEQ - 1 ? *(const u32x4*)(mp + 512) : (u32x4){0u, 0u, 0u, 0u}, xp);
#pragma unroll
                      for (int e = 0; e < 8; ++e) { const float xs = x0[e] + mu8[e] * (0.5f * (xm[e] + xp[e]) - x0[e]); o[e] = isA ? xs : 1.f - 2.f * __builtin_amdgcn_rcpf(1.f + __expf(2.f * xs)); }
                      outv = pack8(o); }
                  *(u32x4*)(dstb + (size_t)row * 256) = outv; } }

        } }
        if (PHEN(3) && ph_lo <= 3 && 3 < ph_hi) { PH_HEADER(); if (3 > ph_lo) grid_barrier((unsigned*)(ws + WS_BAR), xb_st, (unsigned)G, tid);
            for (int i = 0; i * G + bid < 512; ++i) { const int L = i * G + bid; int b, h, qblk;
                if (G == 256) { const int xcd = bid & 7, sI = bid >> 3, idx = i * 32 + sI, pl = idx >> 3; qblk = idx & 7; const int pair = pl * 8 + xcd; b = pair >> 3; h = pair & 7; }
                else { qblk = L & 7; h = (L >> 3) & 7; b = L >> 6; }
                const size_t tok0 = (size_t)b * SEQ;
                att::attn_body(qb + (tok0 + qblk * 256) * 1536 + h * 192, kvb + tok0 * 2048 + h * 256, kvb + tok0 * 2048 + h * 256 + 128, krope + tok0 * 64,
                               zb + (tok0 + qblk * 256) * 2048 + h * 128, SEQ, shm, tid); }
            __syncthreads();
#ifndef NO_LORA
            { S.init(T, 2048, G, bid); EpiLora E{ua, 0, p.w0_f, p.w0_b}; pg8::gemm_phase(glds, pg8::Gemm{Aw, W_lw, T, 2048, 256, 256, 256}, S, E, tid); }
            { S.init(T, 2048, G, bid); EpiLora E{ua, 2048, p.a0_f, p.a0_b}; pg8::gemm_phase(glds, pg8::Gemm{Aa, W_la, T, 2048, 256, 256, 256}, S, E, tid); }
#endif
        }
        if (PHEN(4) && ph_lo <= 4 && 4 < ph_hi) { PH_HEADER(); if (4 > ph_lo) grid_barrier((unsigned*)(ws + WS_BAR), xb_st, (unsigned)G, tid);
        for (int rep_ = 0; rep_ < DBLN(4); ++rep_) {
            for (int c = bid; c < 256; c += G) scan_chain(p, c, shm, tid);

        } }
        if (PHEN(5) && ph_lo <= 5 && 5 < ph_hi) { PH_HEADER(); if (5 > ph_lo) grid_barrier((unsigned*)(ws + WS_BAR), xb_st, (unsigned)G, tid);
            const float* __restrict__ yf = (const float*)(ws + WS_YF); const float* __restrict__ yb = (const float*)(ws + WS_YB);
            const int c8 = lane * 8;
            P5Par pp; { const int chq = (gw & 1) * 512 + c8;
#pragma unroll
                for (int e = 0; e < 8; ++e) { pp.mur[e] = p.mu[chq + e]; pp.muk[e] = p.mu[1024 + chq + e]; pp.muv[e] = p.mu[2048 + chq + e]; pp.ka[e] = p.k_a[chq + e]; pp.rk[e] = p.r_k[chq + e]; pp.gg[e] = p.gn_g[chq + e]; pp.gb[e] = p.gn_b[chq + e]; } }
            for (int it0 = gw; it0 < T * 2; it0 += 2 * NGW) {
                P5In in[2];
#pragma unroll
                for (int k = 0; k < 2; ++k) { const int it = it0 + k * NGW; if (it < T * 2) p5_load(in[k], it, c8, yf, yb, rkv, ua, zb); }
#pragma unroll
                for (int k = 0; k < 2; ++k) { const int it = it0 + k * NGW; if (it < T * 2) p5_finish(in[k], it, c8, pp, zb); }
            }
        }
        if (PHEN(6) && ph_lo <= 6 && 6 < ph_hi) { PH_HEADER(); if (6 > ph_lo) grid_barrier((unsigned*)(ws + WS_BAR), xb_st, (unsigned)G, tid);
        for (int rep_ = 0; rep_ < DBLN(6); ++rep_) {
            { S.init(T, 2048, G, bid); EpiMerge E{gb, merged}; pg8::gemm_phase(glds, pg8::Gemm{zb, W_bm, T, 2048, 2048, 2048, 2048}, S, E, tid); }

        } }
        if (PHEN(7) && ph_lo <= 7 && 7 < ph_hi) { PH_HEADER(); if (7 > ph_lo) grid_barrier((unsigned*)(ws + WS_BAR), xb_st, (unsigned)G, tid);
        for (int rep_ = 0; rep_ < DBLN(7); ++rep_) {
            S.init(T, 2048, G, bid); EpiOut E{(bf16_t*)(ws + WS_ORAW)}; pg8::gemm_phase(glds, pg8::Gemm{merged, W_out, T, 2048, 2048, 2048, 2048}, S, E, tid);

        } }
        if (PHEN(8) && ph_lo <= 8 && 8 < ph_hi) { PH_HEADER(); if (8 > ph_lo) grid_barrier((unsigned*)(ws + WS_BAR), xb_st, (unsigned)G, tid);
            const bf16_t* oraw = (const bf16_t*)(ws + WS_ORAW);
            f32x4 gpost[4][2];
#pragma unroll
            for (int j = 0; j < 4; ++j)
#pragma unroll
                for (int hh = 0; hh < 2; ++hh) gpost[j][hh] = *(const f32x4*)(p.g_post + (j * 64 + lane) * 8 + hh * 4);
            for (int row = gw; row < T; row += NGW) { float* orow = p.out + (size_t)row * DM; const float* xr = p.x + (size_t)row * DM; float v[4][8]; float s = 0.f;
                u32x4 ow[4]; f32x4 xx[4][2];
#pragma unroll
                for (int j = 0; j < 4; ++j) { ow[j] = *(const u32x4*)(oraw + (size_t)row * DM + (j * 64 + lane) * 8);
#pragma unroll
                    for (int hh = 0; hh < 2; ++hh) xx[j][hh] = *(const f32x4*)(xr + (j * 64 + lane) * 8 + hh * 4); }
#pragma unroll
                for (int j = 0; j < 4; ++j) { unpack8(ow[j], v[j]);
#pragma unroll
                    for (int e = 0; e < 8; ++e) s += v[j][e] * v[j][e]; }
                const float rs = rsqrtf(wave_sum_fast(s) * (1.f / DM) + 1e-6f);
#pragma unroll
                for (int j = 0; j < 4; ++j) { const int c = (j * 64 + lane) * 8;
#pragma unroll
                    for (int hh = 0; hh < 2; ++hh) { const f32x4 gg = gpost[j][hh], xv = xx[j][hh];
                        *(f32x4*)(orow + c + hh * 4) = (f32x4){xv[0] + v[j][hh * 4 + 0] * rs * gg[0], xv[1] + v[j][hh * 4 + 1] * rs * gg[1], xv[2] + v[j][hh * 4 + 2] * rs * gg[2], xv[3] + v[j][hh * 4 + 3] * rs * gg[3]}; } } }
        }
}

constexpr int LDS_BYTES = LDS_PHASE_BYTES + 16;
constexpr int NPH = 9;
extern "C" void kernel_launch(void* const* d_in, const int* in_sizes, int n_in, void* d_out, int out_size, void* d_ws, size_t ws_size, hipStream_t stream) {
    static int grid = 0;
    if (grid == 0) {
        if (n_in != 25 || out_size != T * DM || ws_size < WS_END) { fprintf(stderr, "kernel_launch: shape mismatch n_in %d out %d ws %zu (need %zu)\n", n_in, out_size, ws_size, (size_t)WS_END); grid = -1; return; }
        int dev = 0, cus = 0, per_cu = 0;
        if (hipGetDevice(&dev) != hipSuccess || hipDeviceGetAttribute(&cus, hipDeviceAttributeMultiprocessorCount, dev) != hipSuccess) { grid = -1; return; }
        if (hipFuncSetAttribute((const void*)hybrid_fwd, hipFuncAttributeMaxDynamicSharedMemorySize, LDS_BYTES) != hipSuccess) { fprintf(stderr, "kernel_launch: hipFuncSetAttribute failed\n"); grid = -1; return; }
        if (hipOccupancyMaxActiveBlocksPerMultiprocessor(&per_cu, (const void*)hybrid_fwd, 512, LDS_BYTES) != hipSuccess || per_cu < 1) { fprintf(stderr, "kernel_launch: occupancy query says %d\n", per_cu); grid = -1; return; }
        grid = cus;
    }
    if (grid < 0) return;
    Params p{};
    const float** pp = (const float**)&p;
    for (int i = 0; i < 25; ++i) pp[i] = (const float*)d_in[i];
    p.out = (float*)d_out; p.ws = (unsigned char*)d_ws;
    if (hipMemsetAsync((char*)d_ws + WS_BAR, 0, 16384, stream) != hipSuccess) { fprintf(stderr, "kernel_launch: memset failed\n"); return; }
#if N_LAUNCHES == 1
    p.ph_lo = 0; p.ph_hi = NPH;
    void* args[] = {&p};
    hipError_t e = hipLaunchCooperativeKernel((const void*)hybrid_fwd, dim3(grid), dim3(512), args, LDS_BYTES, stream);
    if (e != hipSuccess) fprintf(stderr, "cooperative launch failed: %s (grid %d)\n", hipGetErrorString(e), grid);
#else
    for (int ph = 0; ph < NPH; ++ph) { p.ph_lo = ph; p.ph_hi = ph + 1; hipLaunchKernelGGL(hybrid_fwd, dim3(grid), dim3(512), LDS_BYTES, stream, p); }
#endif
}
```
